# Optimizing an MI355X kernel written in HIP

```python
import functools
import jax, jax.numpy as jnp
from jax import lax
import numpy as np

D_MODEL = 1024
BATCH = 8
SEQ = 4096
DEPTH = 1
DEC_BATCH = 128
DEC_SEQ = 4
PAST_LEN = 16384
PAGE_SIZE = 128

HEAD_DIM = 64
N_HEADS = 8
N_KV_HEADS = 2
GROUP = N_HEADS // N_KV_HEADS
ATTN_DIM = N_HEADS * HEAD_DIM
KV_DIM = N_KV_HEADS * HEAD_DIM
WINDOW = 128
BLOCK = WINDOW
ROPE_THETA = 500000.0
ROPE_DIM = HEAD_DIM // 4
CONV_DIM = D_MODEL // 2
CONV_WIDTH = 31
FFN_DIM = -(-8 * D_MODEL // (3 * 256)) * 256
RMS_EPS = 1e-6
LN_EPS = 1e-5
NEG_INF = -1e30
IN_SIZES = (ATTN_DIM, KV_DIM, KV_DIM, CONV_DIM, CONV_DIM, D_MODEL, D_MODEL)
IN_COLS = sum(IN_SIZES)
IN_SPLITS = tuple(int(s) for s in np.cumsum(IN_SIZES)[:-1])

kernel_name = "hybrid_conformer_conv_swa_sink_decoder_step"


def rms_norm(x, g):
    xf = x.astype(jnp.float32)
    y = xf * lax.rsqrt(jnp.mean(xf * xf, axis=-1, keepdims=True) + RMS_EPS)
    return (y * g.astype(jnp.float32)).astype(x.dtype)


def adaln_mods(c, w_ada, b_ada):
    mods = jax.nn.silu(c) @ w_ada + b_ada
    return jnp.split(mods[:, None, :], 6, axis=-1)


def partial_rope(x, pos):
    half = ROPE_DIM // 2
    inv = ROPE_THETA ** (-jnp.arange(0, ROPE_DIM, 2, dtype=jnp.float32) / ROPE_DIM)
    ang = pos[:, None] * inv[None, :]
    cos = jnp.cos(ang)[:, None, :]
    sin = jnp.sin(ang)[:, None, :]
    xf = x.astype(jnp.float32)
    x1 = xf[..., :half]
    x2 = xf[..., half:ROPE_DIM]
    out = jnp.concatenate([x1 * cos - x2 * sin, x2 * cos + x1 * sin, xf[..., ROPE_DIM:]], axis=-1)
    return out.astype(x.dtype)


def sink_softmax(s, mask, sink):
    s = jnp.where(mask, s, NEG_INF)
    m = jnp.maximum(jnp.max(s, axis=-1, keepdims=True), sink)
    p = jnp.exp(s - m)
    den = jnp.sum(p, axis=-1, keepdims=True) + jnp.exp(sink - m)
    return p / den


def project_mixer_inputs(h, w_in, pos):
    B, T, _ = h.shape
    z = h @ w_in
    q, k, v, glu_a, glu_b, g_att, g_conv = jnp.split(z, IN_SPLITS, axis=-1)
    q = partial_rope(q.reshape(B, T, N_HEADS, HEAD_DIM), pos)
    k = partial_rope(k.reshape(B, T, N_KV_HEADS, HEAD_DIM), pos)
    v = v.reshape(B, T, N_KV_HEADS, HEAD_DIM)
    u = glu_a * jax.nn.sigmoid(glu_b)
    return q, k, v, u, g_att, g_conv


def swa_prompt(q, k, v, sinks):
    B, T = q.shape[:2]
    nb = T // BLOCK
    scale = HEAD_DIM ** -0.5
    qb = q.reshape(B, nb, BLOCK, N_KV_HEADS, GROUP, HEAD_DIM)
    pad = jnp.zeros((B, BLOCK, N_KV_HEADS, HEAD_DIM), k.dtype)
    kp = jnp.concatenate([pad, k], axis=1).reshape(B, nb + 1, BLOCK, N_KV_HEADS, HEAD_DIM)
    vp = jnp.concatenate([pad, v], axis=1).reshape(B, nb + 1, BLOCK, N_KV_HEADS, HEAD_DIM)
    kb = jnp.concatenate([kp[:, :-1], kp[:, 1:]], axis=2)
    vb = jnp.concatenate([vp[:, :-1], vp[:, 1:]], axis=2)
    s = jnp.einsum('bnqkgd,bnskd->bnkgqs', qb, kb, preferred_element_type=jnp.float32) * scale
    blk = jnp.arange(nb)[:, None] * BLOCK
    qpos = blk + jnp.arange(BLOCK)[None, :]
    kpos = blk - BLOCK + jnp.arange(2 * BLOCK)[None, :]
    rel = qpos[:, :, None] - kpos[:, None, :]
    mask = (rel >= 0) & (rel < WINDOW) & (kpos[:, None, :] >= 0)
    mask = mask[None, :, None, None]
    sink = sinks.astype(jnp.float32).reshape(1, 1, N_KV_HEADS, GROUP, 1, 1)
    probs = sink_softmax(s, mask, sink)
    o = jnp.einsum('bnkgqs,bnskd->bnqkgd', probs.astype(v.dtype), vb)
    return o.reshape(B, T, ATTN_DIM)


def swa_sample(q, k_new, v_new, k_buf, v_buf, sinks):
    Bd, S = q.shape[:2]
    L = k_buf.shape[1]
    scale = HEAD_DIM ** -0.5
    kc = jnp.concatenate([k_buf, k_new], axis=1)
    vc = jnp.concatenate([v_buf, v_new], axis=1)
    qg = q.reshape(Bd, S, N_KV_HEADS, GROUP, HEAD_DIM)
    s = jnp.einsum('btkgd,bskd->bkgts', qg, kc, preferred_element_type=jnp.float32) * scale
    qpos = PAST_LEN + jnp.arange(S)
    kpos = PAST_LEN - L + jnp.arange(L + S)
    rel = qpos[:, None] - kpos[None, :]
    mask = ((rel >= 0) & (rel < WINDOW))[None, None, None]
    sink = sinks.astype(jnp.float32).reshape(1, N_KV_HEADS, GROUP, 1, 1)
    probs = sink_softmax(s, mask, sink)
    o = jnp.einsum('bkgts,bskd->btkgd', probs.astype(vc.dtype), vc)
    return o.reshape(Bd, S, ATTN_DIM), kc[:, -L:], vc[:, -L:]


def conv_branch(u_hist, conv_w, conv_b, ln_g, ln_b, w_conv_o):
    dw = lax.conv_general_dilated(u_hist, conv_w[:, None, :], window_strides=(1,), padding='VALID',
                                  dimension_numbers=('NWC', 'WIO', 'NWC'),
                                  feature_group_count=CONV_DIM) + conv_b
    df = dw.astype(jnp.float32)
    mu = jnp.mean(df, axis=-1, keepdims=True)
    var = jnp.mean(jnp.square(df - mu), axis=-1, keepdims=True)
    n = ((df - mu) * lax.rsqrt(var + LN_EPS) * ln_g.astype(jnp.float32) + ln_b.astype(jnp.float32)).astype(dw.dtype)
    return jax.nn.silu(n) @ w_conv_o


def merge_branches(a, cv_out, g_att, g_conv, lw):
    a_out = a @ lw['w_attn_o']
    m = jax.nn.sigmoid(g_att) * a_out + jax.nn.sigmoid(g_conv) * cv_out
    return m @ lw['w_out']


def mixer_prompt(h, lw):
    B, T, _ = h.shape
    pos = jnp.arange(T, dtype=jnp.float32)
    q, k, v, u, g_att, g_conv = project_mixer_inputs(h, lw['w_in'], pos)
    a = swa_prompt(q, k, v, lw['sinks'])
    u_hist = jnp.concatenate([jnp.zeros((B, CONV_WIDTH - 1, CONV_DIM), u.dtype), u], axis=1)
    cv_out = conv_branch(u_hist, lw['conv_w'], lw['conv_b'], lw['conv_ln_g'], lw['conv_ln_b'], lw['w_conv_o'])
    out = merge_branches(a, cv_out, g_att, g_conv, lw)
    L = min(WINDOW, T)
    return out, (k[:, -L:], v[:, -L:], u[:, -(CONV_WIDTH - 1):])


def mixer_sample(h, k_buf, v_buf, conv_buf, lw):
    T = h.shape[1]
    pos = PAST_LEN + jnp.arange(T, dtype=jnp.float32)
    q, k, v, u, g_att, g_conv = project_mixer_inputs(h, lw['w_in'], pos)
    a, k_new_buf, v_new_buf = swa_sample(q, k, v, k_buf, v_buf, lw['sinks'])
    u_hist = jnp.concatenate([conv_buf, u], axis=1)
    cv_out = conv_branch(u_hist, lw['conv_w'], lw['conv_b'], lw['conv_ln_g'], lw['conv_ln_b'], lw['w_conv_o'])
    out = merge_branches(a, cv_out, g_att, g_conv, lw)
    return out, (k_new_buf, v_new_buf, u_hist[:, -(CONV_WIDTH - 1):])


def swiglu(h, w_ffn_in, w_ffn_out):
    g, u = jnp.split(h @ w_ffn_in, 2, axis=-1)
    return (jax.nn.silu(g) * u) @ w_ffn_out


def trunk_layer(x, c, lw, mixer):
    sh1, sc1, g1, sh2, sc2, g2 = adaln_mods(c, lw['w_ada'], lw['b_ada'])
    h = rms_norm(x, lw['norm1_g']) * (1 + sc1) + sh1
    m, states = mixer(h)
    x = x + g1 * m
    h2 = rms_norm(x, lw['norm2_g']) * (1 + sc2) + sh2
    x = x + g2 * swiglu(h2, lw['w_ffn_in'], lw['w_ffn_out'])
    return x, states


def setup_inputs(seed: int = 0) -> dict:
    key = jax.random.key(seed)
    ks = jax.random.split(key, 24)
    f32 = jnp.float32
    nrm = lambda k, shape, s: jax.random.normal(k, shape, f32) * s
    win_rows = min(WINDOW, PAST_LEN)
    return {
        'x_prompt': nrm(ks[0], (BATCH, SEQ, D_MODEL), 1.0),
        'x_sample': nrm(ks[1], (DEC_BATCH, DEC_SEQ, D_MODEL), 1.0),
        'state_k_win': nrm(ks[2], (DEPTH, DEC_BATCH, win_rows, N_KV_HEADS, HEAD_DIM), 1.0),
        'state_v_win': nrm(ks[3], (DEPTH, DEC_BATCH, win_rows, N_KV_HEADS, HEAD_DIM), 1.0),
        'state_conv': nrm(ks[4], (DEPTH, DEC_BATCH, CONV_WIDTH - 1, CONV_DIM), 0.5),
        'c_prompt': nrm(ks[5], (BATCH, D_MODEL), 1.0),
        'c_sample': nrm(ks[6], (DEC_BATCH, D_MODEL), 1.0),
        'norm1_g': 1.0 + nrm(ks[7], (DEPTH, D_MODEL), 0.01),
        'norm2_g': 1.0 + nrm(ks[8], (DEPTH, D_MODEL), 0.01),
        'w_ada': nrm(ks[9], (DEPTH, D_MODEL, 6 * D_MODEL), 0.5 * D_MODEL ** -0.5),
        'b_ada': nrm(ks[10], (DEPTH, 6 * D_MODEL), 0.01),
        'w_in': nrm(ks[11], (DEPTH, D_MODEL, IN_COLS), D_MODEL ** -0.5),
        'sinks': nrm(ks[12], (DEPTH, N_HEADS), 1.0),
        'w_attn_o': nrm(ks[13], (DEPTH, ATTN_DIM, D_MODEL), ATTN_DIM ** -0.5),
        'conv_w': nrm(ks[14], (DEPTH, CONV_WIDTH, CONV_DIM), CONV_WIDTH ** -0.5),
        'conv_b': nrm(ks[15], (DEPTH, CONV_DIM), 0.01),
        'conv_ln_g': 1.0 + nrm(ks[16], (DEPTH, CONV_DIM), 0.01),
        'conv_ln_b': nrm(ks[17], (DEPTH, CONV_DIM), 0.01),
        'w_conv_o': nrm(ks[18], (DEPTH, CONV_DIM, D_MODEL), CONV_DIM ** -0.5),
        'w_out': nrm(ks[19], (DEPTH, D_MODEL, D_MODEL), D_MODEL ** -0.5),
        'w_ffn_in': nrm(ks[20], (DEPTH, D_MODEL, 2 * FFN_DIM), D_MODEL ** -0.5),
        'w_ffn_out': nrm(ks[21], (DEPTH, FFN_DIM, D_MODEL), FFN_DIM ** -0.5),
        'final_norm_g': 1.0 + nrm(ks[22], (D_MODEL,), 0.01),
    }


def reference(x_prompt, x_sample, state_k_win, state_v_win, state_conv, c_prompt, c_sample,
              norm1_g, norm2_g, w_ada, b_ada, w_in, sinks, w_attn_o, conv_w, conv_b,
              conv_ln_g, conv_ln_b, w_conv_o, w_out, w_ffn_in, w_ffn_out, final_norm_g):
    xp, xs = x_prompt, x_sample
    kp_l, vp_l, cp_l, ks_l, vs_l, cs_l = [], [], [], [], [], []
    for l in range(DEPTH):
        lw = dict(norm1_g=norm1_g[l], norm2_g=norm2_g[l], w_ada=w_ada[l], b_ada=b_ada[l],
                  w_in=w_in[l], sinks=sinks[l], w_attn_o=w_attn_o[l], conv_w=conv_w[l],
                  conv_b=conv_b[l], conv_ln_g=conv_ln_g[l], conv_ln_b=conv_ln_b[l],
                  w_conv_o=w_conv_o[l], w_out=w_out[l], w_ffn_in=w_ffn_in[l], w_ffn_out=w_ffn_out[l])
        xp, (kp, vp, cp) = trunk_layer(xp, c_prompt, lw, functools.partial(mixer_prompt, lw=lw))
        xs, (ksn, vsn, csn) = trunk_layer(
            xs, c_sample, lw,
            functools.partial(mixer_sample, k_buf=state_k_win[l], v_buf=state_v_win[l],
                              conv_buf=state_conv[l], lw=lw))
        kp_l.append(kp); vp_l.append(vp); cp_l.append(cp)
        ks_l.append(ksn); vs_l.append(vsn); cs_l.append(csn)
    y_prompt = rms_norm(xp, final_norm_g)
    y_sample = rms_norm(xs, final_norm_g)
    k_win_prompt = jnp.stack(kp_l)
    v_win_prompt = jnp.stack(vp_l)
    conv_prompt = jnp.stack(cp_l)
    k_win_sample = jnp.stack(ks_l)
    v_win_sample = jnp.stack(vs_l)
    conv_sample = jnp.stack(cs_l)
    return (y_prompt, y_sample, k_win_prompt, v_win_prompt, conv_prompt, k_win_sample, v_win_sample, conv_sample)
```

```cpp
#include <hip/hip_runtime.h>
#include <hip/hip_cooperative_groups.h>
#include <cstdio>
namespace cg = cooperative_groups;
namespace pg8 {
#define PG8_LAS __attribute__((address_space(3)))
typedef unsigned short bf16_t;
typedef short bf16x8 __attribute__((ext_vector_type(8)));
typedef float f32x4 __attribute__((ext_vector_type(4)));
typedef unsigned u32x4 __attribute__((ext_vector_type(4)));
constexpr int BM = 256, BK = 64, HALF = 128, HTB = HALF * BK * 2  , STAGE_BYTES = 8 * HTB, NXCD = 8, WGM = 8;

__host__ __device__ __forceinline__ int lds_byte(int r, int c) { const int st = (r >> 4) * 2 + (c >> 5), rr = r & 15, cc = c & 31, ob = rr * 64 + cc * 2; return st * 1024 + (ob ^ (((ob >> 9) & 1) << 5)); }
__host__ __device__ __forceinline__ void stage_rc(int b, int& R, int& C) { const int st = b / 1024, sb = b % 1024, swz = sb ^ (((sb >> 9) & 1) << 5); R = (st >> 1) * 16 + swz / 64; C = (st & 1) * 32 + (swz % 64) / 2; }
__host__ __device__ __forceinline__ int perm32(int rho) { const int n = rho >> 4, i = rho & 15; return 8 * (i >> 2) + 4 * n + (i & 3); }

struct Unit { int pm, pn; };
struct Gemm { const bf16_t* A; const bf16_t* Bt; int M, N, K; };

struct StaticOrder {
    int nM, nN, nwg, G, c;
    __host__ __device__ void init(int M, int N, int G_, int c_) { nM = M / BM; nN = N / BM; nwg = nM * nN; G = G_; c = c_; }
    __host__ __device__ bool next(int i, Unit& u) const {
        const long L = (long)i * G + c; if (L >= nwg) return false;
        int wgid = (int)L; { const int q = nwg / NXCD, r = nwg % NXCD, xcd = wgid % NXCD, off = wgid / NXCD; wgid = (xcd < r ? xcd * (q + 1) : r * (q + 1) + (xcd - r) * q) + off; }
        const int nig = WGM * nN, gid = wgid / nig, fm = gid * WGM, gsz = (nM - fm) < WGM ? (nM - fm) : WGM;
        u.pm = fm + ((wgid % nig) % gsz); u.pn = (wgid % nig) / gsz; return true;
    }
    __device__ __forceinline__ void a_ready(const Unit&) const {}
    __device__ __forceinline__ void done(const Unit&) const {}
};
__device__ __forceinline__ unsigned cvt_pk_bf16(float lo, float hi) { unsigned r; asm volatile("v_cvt_pk_bf16_f32 %0, %1, %2" : "=v"(r) : "v"(lo), "v"(hi)); return r; }
template <class Epi, class Sched, bool STAMP = false>
__device__ __forceinline__ void gemm_phase(PG8_LAS unsigned char* lds, const Gemm g, const Sched& S, const Epi& E, unsigned long long* stamps) {
    const int tid = threadIdx.x, wid = __builtin_amdgcn_readfirstlane(tid >> 6), lane = tid & 63, wr = wid >> 2, wc = wid & 3, fr = lane & 15, fq = lane >> 4;
    const int K = g.K, nt = K / BK;
    int ts_lo = 0, ts_hi = 0, nts = 0; const unsigned long long rt_entry = STAMP ? (unsigned long long)wall_clock64() : 0ull;
#define PG8_STAMP() do { if (STAMP && wid == 0 && nts < 64) { const unsigned long long _c = (unsigned long long)clock64(); \
        ts_lo = (lane == nts) ? (int)(unsigned)_c : ts_lo; ts_hi = (lane == nts) ? (int)(unsigned)(_c >> 32) : ts_hi; ++nts; } } while (0)
    PG8_STAMP();
    unsigned voffA[2], voffB[2];
#pragma unroll
    for (int i = 0; i < 2; ++i) { int R, C; stage_rc(tid * 16 + i * 8192, R, C); const int Rb = Epi::PERM ? ((R & ~31) + perm32(R & 31)) : R;
        voffA[i] = (unsigned)(R * K + C) * 2u; voffB[i] = (unsigned)(Rb * K + C) * 2u; }
    const size_t kstep = (size_t)(BK * 2);
    const size_t hstep = (size_t)HALF * K * 2;
    const size_t tstep = 2 * hstep;
    const unsigned ldsw = (unsigned)wid * 1024u;
    const int aoff = lds_byte(wr * 64 + fr, fq * 8), boff = lds_byte(wc * 32 + fr, fq * 8);
#define PG8_SA(b, h) (((b) * 2 + (h)) * HTB)
#define PG8_SB(b, h) ((4 + (b) * 2 + (h)) * HTB)
#define PG8_STAGE(bufoff, gbase, voff) do { _Pragma("unroll") for (int _i = 0; _i < 2; ++_i) \
        __builtin_amdgcn_global_load_lds((const unsigned*)((const char*)(gbase) + (voff)[_i]), (PG8_LAS unsigned*)(lds + (bufoff) + ldsw + _i * 8192), 16, 0, 0); } while (0)
#define PG8_LDA(dst, b, h) do { _Pragma("unroll") for (int m = 0; m < 4; ++m) _Pragma("unroll") for (int k = 0; k < 2; ++k) dst[m][k] = *(const PG8_LAS bf16x8*)(lds + PG8_SA(b, h) + aoff + m * 2048 + k * 1024); } while (0)
#define PG8_LDB(dst, b, h) do { _Pragma("unroll") for (int n = 0; n < 2; ++n) _Pragma("unroll") for (int k = 0; k < 2; ++k) dst[n][k] = *(const PG8_LAS bf16x8*)(lds + PG8_SB(b, h) + boff + n * 2048 + k * 1024); } while (0)
#define PG8_MMA(ai, bj, At, Bt) do { __builtin_amdgcn_s_setprio(1); _Pragma("unroll") for (int m = 0; m < 4; ++m) _Pragma("unroll") for (int n = 0; n < 2; ++n) _Pragma("unroll") for (int k = 0; k < 2; ++k) \
        acc[ai][bj][m][n] = __builtin_amdgcn_mfma_f32_16x16x32_bf16(Bt[n][k], At[m][k], acc[ai][bj][m][n], 0, 0, 0); __builtin_amdgcn_s_setprio(0); } while (0)
#define PG8_WAIT_V(n) asm volatile("s_waitcnt vmcnt(" #n ")" ::: "memory")
#define PG8_WAIT_L(n) asm volatile("s_waitcnt lgkmcnt(" #n ")" ::: "memory")
#define PG8_BAR __builtin_amdgcn_s_barrier()
#define PG8_SCHED __builtin_amdgcn_sched_barrier(0)
    Unit cur, nxt; int ui = 0;
    if (!S.next(0, cur)) return;
    f32x4 acc[2][2][4][2];
#pragma unroll
    for (int a = 0; a < 2; ++a)
#pragma unroll
        for (int b = 0; b < 2; ++b)
#pragma unroll
            for (int m = 0; m < 4; ++m)
#pragma unroll
                for (int n = 0; n < 2; ++n) acc[a][b][m][n] = (f32x4){0.f, 0.f, 0.f, 0.f};
    bf16x8 At[4][2], B0[2][2], B1[2][2];
    const char* cA = (const char*)g.A + (size_t)cur.pm * tstep; const char* cB = (const char*)g.Bt + (size_t)cur.pn * tstep;
    S.a_ready(cur);
    PG8_STAGE(PG8_SB(0, 0), cB, voffB); PG8_STAGE(PG8_SA(0, 0), cA, voffA); PG8_STAGE(PG8_SB(0, 1), cB + hstep, voffB); PG8_STAGE(PG8_SA(0, 1), cA + hstep, voffA);
    if (wr == 1) PG8_BAR;
    PG8_WAIT_V(4); PG8_BAR;
    PG8_STAGE(PG8_SB(1, 0), cB + kstep, voffB); PG8_STAGE(PG8_SA(1, 0), cA + kstep, voffA); PG8_STAGE(PG8_SB(1, 1), cB + hstep + kstep, voffB);
    PG8_WAIT_V(6); PG8_BAR;
    PG8_STAMP();
    for (;;) {
        const bool has_next = S.next(ui + 1, nxt);
        const char* nA = has_next ? (const char*)g.A + (size_t)nxt.pm * tstep : cA; const char* nB = has_next ? (const char*)g.Bt + (size_t)nxt.pn * tstep : cB;
        for (int t = 0; t < nt; t += 2) {
            const bool last = (t == nt - 2);
            const char* a1 = cA + (size_t)(t + 1) * kstep;
            const char* a2 = last ? nA : cA + (size_t)(t + 2) * kstep; const char* b2 = last ? nB : cB + (size_t)(t + 2) * kstep;
            const char* a3 = a2 + kstep; const char* b3 = b2 + kstep;
            if (last && has_next) S.a_ready(nxt);
            PG8_LDB(B0, 0, 0); PG8_SCHED; PG8_LDA(At, 0, 0); PG8_STAGE(PG8_SA(1, 1), a1 + hstep, voffA);
            PG8_WAIT_L(8); PG8_BAR; PG8_WAIT_L(0); PG8_MMA(0, 0, At, B0); PG8_BAR; PG8_SCHED;
            PG8_LDB(B1, 0, 1); PG8_STAGE(PG8_SB(0, 0), b2, voffB);
            PG8_BAR; PG8_WAIT_L(0); PG8_MMA(0, 1, At, B1); PG8_BAR;
            PG8_LDA(At, 0, 1); PG8_STAGE(PG8_SA(0, 0), a2, voffA);
            PG8_BAR; PG8_WAIT_L(0); PG8_MMA(1, 0, At, B0); PG8_BAR; PG8_SCHED;
            PG8_STAGE(PG8_SB(0, 1), b2 + hstep, voffB);
            PG8_WAIT_V(6); PG8_BAR; PG8_MMA(1, 1, At, B1); PG8_BAR;
            PG8_LDB(B0, 1, 0); PG8_SCHED; PG8_LDA(At, 1, 0); PG8_STAGE(PG8_SA(0, 1), a2 + hstep, voffA);
            PG8_WAIT_L(8); PG8_BAR; PG8_WAIT_L(0); PG8_MMA(0, 0, At, B0); PG8_BAR; PG8_SCHED;
            PG8_LDB(B1, 1, 1); PG8_STAGE(PG8_SB(1, 0), b3, voffB);
            PG8_BAR; PG8_WAIT_L(0); PG8_MMA(0, 1, At, B1); PG8_BAR;
            PG8_LDA(At, 1, 1); PG8_STAGE(PG8_SA(1, 0), a3, voffA);
            PG8_BAR; PG8_WAIT_L(0); PG8_MMA(1, 0, At, B0); PG8_BAR; PG8_SCHED;
            PG8_STAGE(PG8_SB(1, 1), b3 + hstep, voffB);
            PG8_WAIT_V(6); PG8_BAR; PG8_MMA(1, 1, At, B1); PG8_BAR;
        }
        PG8_STAMP();
        if constexpr (!Epi::AFTER_DRAIN) { E(acc, cur, wr, wc, fr, fq); S.done(cur); }
        PG8_STAMP();
        if (!has_next) break;
#pragma unroll
        for (int a = 0; a < 2; ++a)
#pragma unroll
            for (int b = 0; b < 2; ++b)
#pragma unroll
                for (int m = 0; m < 4; ++m)
#pragma unroll
                    for (int n = 0; n < 2; ++n) acc[a][b][m][n] = (f32x4){0.f, 0.f, 0.f, 0.f};
        cur = nxt; cA = nA; cB = nB; ++ui;
    }
    PG8_WAIT_V(0);
    if (wr == 0) PG8_BAR;
    PG8_BAR;
    if constexpr (Epi::AFTER_DRAIN) { E.fused(acc, cur, wr, wc, fr, fq, lds, wid, lane); S.done(cur); }
    PG8_STAMP();
    if (STAMP && wid == 0) { stamps[lane] = lane < nts ? (((unsigned long long)(unsigned)ts_hi << 32) | (unsigned)ts_lo) : 0ull;
        if (lane == 62) stamps[62] = rt_entry; if (lane == 63) stamps[63] = (unsigned long long)wall_clock64(); }
#undef PG8_STAMP
#undef PG8_SA
#undef PG8_SB
#undef PG8_STAGE
#undef PG8_LDA
#undef PG8_LDB
#undef PG8_MMA
#undef PG8_WAIT_V
#undef PG8_WAIT_L
#undef PG8_BAR
#undef PG8_SCHED
}
}
using pg8::bf16_t; using pg8::bf16x8; using pg8::f32x4; using pg8::u32x4; using pg8::Unit; using pg8::cvt_pk_bf16;
#define LAS __attribute__((address_space(3)))
typedef unsigned u32x2 __attribute__((ext_vector_type(2)));
typedef float f32x2 __attribute__((ext_vector_type(2)));

constexpr int D = 1024, TP = 32768, TS = 512, MT = TP + TS, NIN = 3840, FF = 2816, NMOD = 6144;
constexpr size_t MiB = 1u << 20;
constexpr size_t WS_MODS = 1 * MiB, WS_WIN = 5 * MiB, WS_WAO = 13 * MiB, WS_WCO = 14 * MiB, WS_WOUT = 15 * MiB, WS_WF1 = 17 * MiB, WS_WF2 = 28 * MiB,
                 WS_H = 34 * MiB, WS_Q = 99 * MiB, WS_K = 132 * MiB, WS_V = 141 * MiB, WS_U = 150 * MiB, WS_GA = 183 * MiB, WS_GC = 248 * MiB,
                 WS_ATT = 313 * MiB, WS_CV = 346 * MiB, WS_MM = 379 * MiB, WS_ACT = 99 * MiB, WS_END = 444 * MiB;
constexpr size_t O_YS = 33554432, O_KP = 34078720, O_VP = 34209792, O_CP = 34340864, O_KS = 34463744, O_VS = 36560896, O_CS = 38658048;
constexpr int LDS_BYTES = 147456;
constexpr int NPH = 10;

__device__ __forceinline__ float bf2f(unsigned short b) { return __uint_as_float(((unsigned)b) << 16); }
__device__ __forceinline__ float sigm(float x) { return 1.0f / (1.0f + __expf(-x)); }
__device__ __forceinline__ float wave_sum(float v) {
#pragma unroll
    for (int o = 1; o < 64; o <<= 1) v += __shfl_xor(v, o);
    return v;
}
__device__ __forceinline__ float wave_max(float v) {
#pragma unroll
    for (int o = 1; o < 64; o <<= 1) v = fmaxf(v, __shfl_xor(v, o));
    return v;
}
__device__ __forceinline__ int mod_row(int r) { return r < TP ? (r >> 12) : 8 + ((r - TP) >> 2); }
__device__ __forceinline__ void unpack8(const u32x4 w, float (&f)[8]) {
    f[0] = __uint_as_float(w.x << 16); f[1] = __uint_as_float(w.x & 0xffff0000u); f[2] = __uint_as_float(w.y << 16); f[3] = __uint_as_float(w.y & 0xffff0000u);
    f[4] = __uint_as_float(w.z << 16); f[5] = __uint_as_float(w.z & 0xffff0000u); f[6] = __uint_as_float(w.w << 16); f[7] = __uint_as_float(w.w & 0xffff0000u);
}

struct Args { const float* in[23]; float* out; unsigned char* ws; int ph_lo, ph_hi; };
enum { I_XP = 0, I_XS, I_SK, I_SV, I_SC, I_CP, I_CS, I_N1, I_N2, I_WADA, I_BADA, I_WIN, I_SINKS, I_WAO, I_CONVW, I_CONVB, I_LNG, I_LNB, I_WCO, I_WOUT, I_WF1, I_WF2, I_FNG };

__device__ __forceinline__ void transpose_item(const float* W, int K, int N, bf16_t* WT, int which, LAS float* scr, int item, int lane) {
    const int nblk = N / 32, kb = item / nblk, nb = item % nblk, k0 = 64 * kb, n0 = 32 * nb;
#pragma unroll 8
    for (int i = 0; i < 32; ++i) { const int kk = 2 * i + (lane >> 5); scr[kk * 33 + (lane & 31)] = W[(size_t)(k0 + kk) * N + n0 + (lane & 31)]; }
    asm volatile("s_waitcnt lgkmcnt(0)" ::: "memory");
    int drow = n0;
    if (which == 1) { if (n0 >= 768 && n0 < 1280) { const int ch = n0 - 768; drow = 768 + 256 * (ch >> 7) + (ch & 127); } else if (n0 >= 1280 && n0 < 1792) { const int ch = n0 - 1280; drow = 768 + 256 * (ch >> 7) + 128 + (ch & 127); } }
    else if (which == 2) { if (n0 < FF) drow = 256 * (n0 >> 7) + (n0 & 127); else { const int ch = n0 - FF; drow = 256 * (ch >> 7) + 128 + (ch & 127); } }
    const int c = lane & 7;
#pragma unroll
    for (int j = 0; j < 4; ++j) { const int n = (lane >> 3) + 8 * j; const LAS float* s = scr + (8 * c) * 33 + n;
        u32x4 o; o.x = cvt_pk_bf16(s[0 * 33], s[1 * 33]); o.y = cvt_pk_bf16(s[2 * 33], s[3 * 33]); o.z = cvt_pk_bf16(s[4 * 33], s[5 * 33]); o.w = cvt_pk_bf16(s[6 * 33], s[7 * 33]);
        *(u32x4*)(WT + (size_t)(drow + n) * K + k0 + 8 * c) = o; }
    asm volatile("s_waitcnt lgkmcnt(0)" ::: "memory");
}

__device__ __forceinline__ void mods_item(LAS unsigned char* lds, const float* cp, const float* cs, const float* wada, const float* bada, float* mods, int item, int tid) {
    const int rg = item / 24, cb = item % 24;
    LAS float* sc = (LAS float*)lds;
    LAS float* red = (LAS float*)(lds + 81920);
    for (int idx = tid; idx < 17 * 1024; idx += 512) { const int r = idx >> 10, k = idx & 1023, row = rg * 17 + r;
        const float cv = row < 8 ? cp[row * 1024 + k] : cs[(row - 8) * 1024 + k]; sc[k * 20 + r] = cv * sigm(cv); }
    __syncthreads();
    const int col = cb * 256 + (tid & 255), kh = tid >> 8;
    float acc[17];
#pragma unroll
    for (int r = 0; r < 17; ++r) acc[r] = 0.f;
    const float* wp = wada + (size_t)(kh * 512) * NMOD + col;
#pragma unroll 4
    for (int k = 0; k < 512; ++k) {
        const float w = wp[(size_t)k * NMOD];
        const LAS float* s = sc + (kh * 512 + k) * 20;
        const f32x4 s0 = *(const LAS f32x4*)s, s1 = *(const LAS f32x4*)(s + 4), s2 = *(const LAS f32x4*)(s + 8), s3 = *(const LAS f32x4*)(s + 12); const float s4 = s[16];
        acc[0] += s0.x * w; acc[1] += s0.y * w; acc[2] += s0.z * w; acc[3] += s0.w * w;
        acc[4] += s1.x * w; acc[5] += s1.y * w; acc[6] += s1.z * w; acc[7] += s1.w * w;
        acc[8] += s2.x * w; acc[9] += s2.y * w; acc[10] += s2.z * w; acc[11] += s2.w * w;
        acc[12] += s3.x * w; acc[13] += s3.y * w; acc[14] += s3.z * w; acc[15] += s3.w * w; acc[16] += s4 * w;
    }
    if (kh == 1) {
#pragma unroll
        for (int r = 0; r < 17; ++r) red[r * 256 + (tid & 255)] = acc[r];
    }
    __syncthreads();
    if (kh == 0) { const float bb = bada[col];
#pragma unroll
        for (int r = 0; r < 17; ++r) mods[(size_t)(rg * 17 + r) * NMOD + col] = acc[r] + red[r * 256 + tid] + bb; }
    __syncthreads();
}

__device__ __forceinline__ void rows_norm_mod(const float* basep, const float* bases, const float* ng, const float* mods, int chunk_sh, bf16_t* H, int gw, int ngw, int lane) {
    for (int wi = gw; wi < MT / 4; wi += ngw) {
        const int r0 = wi * 4; const float* mp = mods + (size_t)mod_row(r0) * NMOD + chunk_sh * 1024;
        f32x4 gm[4], sh[4];
#pragma unroll
        for (int j = 0; j < 4; ++j) { const int c = 4 * lane + 256 * j; const f32x4 g = *(const f32x4*)(ng + c), s = *(const f32x4*)(mp + 1024 + c); gm[j] = g * (s + 1.0f); sh[j] = *(const f32x4*)(mp + c); }
#pragma unroll
        for (int rr = 0; rr < 4; ++rr) {
            const int r = r0 + rr; const float* xr = r < TP ? basep + (size_t)r * D : bases + (size_t)(r - TP) * D;
            f32x4 v[4]; float ss = 0.f;
#pragma unroll
            for (int j = 0; j < 4; ++j) { v[j] = *(const f32x4*)(xr + 4 * lane + 256 * j); ss += (v[j].x * v[j].x + v[j].y * v[j].y) + (v[j].z * v[j].z + v[j].w * v[j].w); }
            const float rinv = rsqrtf(wave_sum(ss) * (1.0f / D) + 1e-6f);
#pragma unroll
            for (int j = 0; j < 4; ++j) { const f32x4 o = v[j] * rinv * gm[j] + sh[j]; u32x2 w; w.x = cvt_pk_bf16(o.x, o.y); w.y = cvt_pk_bf16(o.z, o.w);
                *(u32x2*)(H + (size_t)r * D + 4 * lane + 256 * j) = w; }
        }
    }
}
__device__ __forceinline__ void rows_final(float* out, const float* g, int gw, int ngw, int lane) {
    f32x4 gm[4];
#pragma unroll
    for (int j = 0; j < 4; ++j) gm[j] = *(const f32x4*)(g + 4 * lane + 256 * j);
    for (int r = gw; r < MT; r += ngw) {
        float* xr = out + (size_t)r * D; f32x4 v[4]; float ss = 0.f;
#pragma unroll
        for (int j = 0; j < 4; ++j) { v[j] = *(const f32x4*)(xr + 4 * lane + 256 * j); ss += (v[j].x * v[j].x + v[j].y * v[j].y) + (v[j].z * v[j].z + v[j].w * v[j].w); }
        const float rinv = rsqrtf(wave_sum(ss) * (1.0f / D) + 1e-6f);
#pragma unroll
        for (int j = 0; j < 4; ++j) *(f32x4*)(xr + 4 * lane + 256 * j) = v[j] * rinv * gm[j];
    }
}
__device__ __forceinline__ u32x4 pack8(const f32x4 a, const f32x4 b) { u32x4 w; w.x = cvt_pk_bf16(a.x, a.y); w.y = cvt_pk_bf16(a.z, a.w); w.z = cvt_pk_bf16(b.x, b.y); w.w = cvt_pk_bf16(b.z, b.w); return w; }

struct EpiIn {
    static constexpr bool PERM = true, AFTER_DRAIN = false;
    bf16_t *Q, *K, *V, *U, *GA, *GC; float* out;
    __device__ __forceinline__ void operator()(const f32x4 (&acc)[2][2][4][2], const Unit& u, int wr, int wc, int fr, int fq) const {
        const int rowb = u.pm * 256 + wr * 64 + fr, cl = wc * 32 + 8 * fq, pn = u.pn;
        const bool sample = u.pm >= 128;
        if (pn <= 2) {
            const bool do_rope = (wc & 1) == 0;
            constexpr double INV2PI[8] = {0.15915494309189535, 0.03086376340470123, 0.005985185712713705, 0.001160663641240061, 0.00022507907903927653, 4.364795279280289e-05, 8.464330808241401e-06, 1.6414262627950345e-06};
#pragma unroll
            for (int ai = 0; ai < 2; ++ai)
#pragma unroll
                for (int m = 0; m < 4; ++m) {
                    const int r = rowb + ai * 128 + m * 16;
                    const int pos = sample ? 16384 + ((r - TP) & 3) : (r & 4095);
                    f32x4 v[2][2];
#pragma unroll
                    for (int bj = 0; bj < 2; ++bj)
#pragma unroll
                        for (int n = 0; n < 2; ++n) v[bj][n] = acc[ai][bj][m][n];
                    if (do_rope) {
#pragma unroll
                        for (int n = 0; n < 2; ++n)
#pragma unroll
                            for (int i = 0; i < 4; ++i) {
                                const double x = (double)pos * INV2PI[4 * n + i];
                                const float fx = (float)(x - __builtin_floor(x));
                                const float cs = __builtin_amdgcn_cosf(fx), sn = __builtin_amdgcn_sinf(fx);
#pragma unroll
                                for (int bj = 0; bj < 2; ++bj) {
                                    if (bj == 1 && pn == 2) continue;
                                    const float mine = v[bj][n][i], other = __shfl_xor(mine, 16);
                                    const float rot = (fq == 0) ? (mine * cs - other * sn) : (mine * cs + other * sn);
                                    v[bj][n][i] = (fq < 2) ? rot : mine;
                                }
                            }
                    }
                    if (pn < 2) {
#pragma unroll
                        for (int bj = 0; bj < 2; ++bj) *(u32x4*)(Q + (size_t)r * 512 + pn * 256 + bj * 128 + cl) = pack8(v[bj][0] * 0.125f, v[bj][1] * 0.125f);
                    } else {
                        *(u32x4*)(K + (size_t)r * 128 + cl) = pack8(v[0][0], v[0][1]);
                        *(u32x4*)(V + (size_t)r * 128 + cl) = pack8(v[1][0], v[1][1]);
                        if (!sample) { const int t = r & 4095;
                            if (t >= 3968) { const size_t o = ((size_t)((r >> 12) * 128 + t - 3968)) * 128 + cl;
                                *(f32x4*)(out + O_KP + o) = v[0][0]; *(f32x4*)(out + O_KP + o + 4) = v[0][1]; *(f32x4*)(out + O_VP + o) = v[1][0]; *(f32x4*)(out + O_VP + o + 4) = v[1][1]; }
                        } else { const int bs = (r - TP) >> 2, t = (r - TP) & 3; const size_t o = ((size_t)(bs * 128 + 124 + t)) * 128 + cl;
                            *(f32x4*)(out + O_KS + o) = v[0][0]; *(f32x4*)(out + O_KS + o + 4) = v[0][1]; *(f32x4*)(out + O_VS + o) = v[1][0]; *(f32x4*)(out + O_VS + o + 4) = v[1][1]; }
                    }
                }
        } else if (pn <= 6) {
            const int chb = 128 * (pn - 3) + cl;
#pragma unroll
            for (int ai = 0; ai < 2; ++ai)
#pragma unroll
                for (int m = 0; m < 4; ++m) {
                    const int r = rowb + ai * 128 + m * 16;
                    f32x4 uu[2];
#pragma unroll
                    for (int n = 0; n < 2; ++n)
#pragma unroll
                        for (int i = 0; i < 4; ++i) uu[n][i] = acc[ai][0][m][n][i] * sigm(acc[ai][1][m][n][i]);
                    *(u32x4*)(U + (size_t)r * 512 + chb) = pack8(uu[0], uu[1]);
                    if (!sample) { const int t = r & 4095;
                        if (t >= 4066) { const size_t o = ((size_t)((r >> 12) * 30 + t - 4066)) * 512 + chb; *(f32x4*)(out + O_CP + o) = uu[0]; *(f32x4*)(out + O_CP + o + 4) = uu[1]; }
                    } else { const int bs = (r - TP) >> 2, t = (r - TP) & 3; const size_t o = ((size_t)(bs * 30 + 26 + t)) * 512 + chb; *(f32x4*)(out + O_CS + o) = uu[0]; *(f32x4*)(out + O_CS + o + 4) = uu[1]; }
                }
        } else {
            bf16_t* G = pn < 11 ? GA : GC; const int cb = 256 * ((pn - 7) & 3) + cl;
#pragma unroll
            for (int ai = 0; ai < 2; ++ai)
#pragma unroll
                for (int m = 0; m < 4; ++m) {
                    const int r = rowb + ai * 128 + m * 16;
#pragma unroll
                    for (int bj = 0; bj < 2; ++bj) { f32x4 a = acc[ai][bj][m][0], b = acc[ai][bj][m][1];
#pragma unroll
                        for (int i = 0; i < 4; ++i) { a[i] = sigm(a[i]); b[i] = sigm(b[i]); }
                        *(u32x4*)(G + (size_t)r * D + cb + bj * 128) = pack8(a, b); }
                }
        }
    }
};

template <int MODE> struct EpiGate {
    static constexpr bool PERM = true, AFTER_DRAIN = false;
    const bf16_t* G; bf16_t* MM;
    __device__ __forceinline__ void operator()(const f32x4 (&acc)[2][2][4][2], const Unit& u, int wr, int wc, int fr, int fq) const {
        const int rowb = u.pm * 256 + wr * 64 + fr, cb = u.pn * 256 + wc * 32 + 8 * fq;
#pragma unroll
        for (int ai = 0; ai < 2; ++ai)
#pragma unroll
            for (int m = 0; m < 4; ++m) {
                const size_t ro = (size_t)(rowb + ai * 128 + m * 16) * D + cb;
#pragma unroll
                for (int bj = 0; bj < 2; ++bj) {
                    float g[8]; unpack8(*(const u32x4*)(G + ro + bj * 128), g);
                    f32x4 a = acc[ai][bj][m][0], b = acc[ai][bj][m][1];
                    a.x *= g[0]; a.y *= g[1]; a.z *= g[2]; a.w *= g[3]; b.x *= g[4]; b.y *= g[5]; b.z *= g[6]; b.w *= g[7];
                    if (MODE == 1) { float p[8]; unpack8(*(const u32x4*)(MM + ro + bj * 128), p); a.x += p[0]; a.y += p[1]; a.z += p[2]; a.w += p[3]; b.x += p[4]; b.y += p[5]; b.z += p[6]; b.w += p[7]; }
                    *(u32x4*)(MM + ro + bj * 128) = pack8(a, b);
                }
            }
    }
};

struct EpiRes {
    static constexpr bool PERM = false, AFTER_DRAIN = false;
    const float* basep; const float* bases; const float* gate; float* out;
    __device__ __forceinline__ void operator()(const f32x4 (&acc)[2][2][4][2], const Unit& u, int wr, int wc, int fr, int fq) const {
        const int rowb = u.pm * 256 + wr * 64 + fr, cb = u.pn * 256 + wc * 32 + 4 * fq;
#pragma unroll
        for (int ai = 0; ai < 2; ++ai)
#pragma unroll
            for (int m = 0; m < 4; ++m) {
                const int r = rowb + ai * 128 + m * 16;
                const float* br = (r < TP ? basep + (size_t)r * D : bases + (size_t)(r - TP) * D) + cb;
                const float* gr = gate + (size_t)mod_row(r) * NMOD + cb; float* orow = out + (size_t)r * D + cb;
#pragma unroll
                for (int bj = 0; bj < 2; ++bj)
#pragma unroll
                    for (int n = 0; n < 2; ++n) { const int o = bj * 128 + n * 16; *(f32x4*)(orow + o) = *(const f32x4*)(br + o) + *(const f32x4*)(gr + o) * acc[ai][bj][m][n]; }
            }
    }
};

struct EpiSwi {
    static constexpr bool PERM = true, AFTER_DRAIN = false;
    bf16_t* ACT;
    __device__ __forceinline__ void operator()(const f32x4 (&acc)[2][2][4][2], const Unit& u, int wr, int wc, int fr, int fq) const {
        const int rowb = u.pm * 256 + wr * 64 + fr, cb = u.pn * 128 + wc * 32 + 8 * fq;
#pragma unroll
        for (int ai = 0; ai < 2; ++ai)
#pragma unroll
            for (int m = 0; m < 4; ++m) {
                f32x4 uu[2];
#pragma unroll
                for (int n = 0; n < 2; ++n)
#pragma unroll
                    for (int i = 0; i < 4; ++i) { const float g = acc[ai][0][m][n][i]; uu[n][i] = g * sigm(g) * acc[ai][1][m][n][i]; }
                *(u32x4*)(ACT + (size_t)(rowb + ai * 128 + m * 16) * FF + cb) = pack8(uu[0], uu[1]);
            }
    }
};
#define MFMA16(a, b, c) __builtin_amdgcn_mfma_f32_16x16x32_bf16((a), (b), (c), 0, 0, 0)
constexpr int ATT_VT_OFF = 39168, SATT_OFF = 77824, CONV_RED_OFF = 110592;
__device__ __forceinline__ void attn_prompt_item(LAS unsigned char* lds, const bf16_t* Q, const bf16_t* Kb, const bf16_t* Vb, bf16_t* ATT, const float* sinks, int item, int tid) {
    const int b = item >> 6, blk = (item >> 1) & 31, kvh = item & 1;
    const int tok0 = b * 4096 + blk * 128;
    LAS bf16_t* Ks = (LAS bf16_t*)lds;
    LAS bf16_t* Vt = (LAS bf16_t*)(lds + ATT_VT_OFF);
#pragma unroll
    for (int it = 0; it < 4; ++it) {
        const int c = tid + it * 512, key = c >> 3, part = c & 7;
        u32x4 kv = {0u, 0u, 0u, 0u}, vv = {0u, 0u, 0u, 0u};
        if (blk > 0 || key >= 128) { const size_t g = (size_t)(tok0 - 128 + key) * 128 + kvh * 64 + part * 8; kv = *(const u32x4*)(Kb + g); vv = *(const u32x4*)(Vb + g); }
        *(LAS u32x4*)(Ks + key * 72 + part * 8) = kv;
        LAS bf16_t* vp = Vt + (part * 8) * 280 + key;
        vp[0 * 280] = (bf16_t)(vv.x & 0xffffu); vp[1 * 280] = (bf16_t)(vv.x >> 16); vp[2 * 280] = (bf16_t)(vv.y & 0xffffu); vp[3 * 280] = (bf16_t)(vv.y >> 16);
        vp[4 * 280] = (bf16_t)(vv.z & 0xffffu); vp[5 * 280] = (bf16_t)(vv.z >> 16); vp[6 * 280] = (bf16_t)(vv.w & 0xffffu); vp[7 * 280] = (bf16_t)(vv.w >> 16);
    }
    for (int i = tid; i < 576; i += 512) ((LAS unsigned*)(Ks + 256 * 72))[i] = 0u;
    for (int i = tid; i < 1536; i += 512) { const int r = i / 24, c = i % 24; Vt[r * 280 + 256 + c] = 0; }
    __syncthreads();
    const int w = tid >> 6, lane = tid & 63, l15 = lane & 15, q4 = lane >> 4;
    const int h = kvh * 4 + (w >> 1), qh = w & 1;
    const float sink = sinks[h];
    for (int qt = 0; qt < 4; ++qt) {
        const int qi0 = qh * 64 + qt * 16;
        const bf16_t* qp = Q + (size_t)(tok0 + qi0 + l15) * 512 + h * 64 + 8 * q4;
        const bf16x8 qf0 = *(const bf16x8*)qp, qf1 = *(const bf16x8*)(qp + 32);
        f32x4 s[10];
#pragma unroll
        for (int kt = 0; kt < 10; ++kt) {
            const LAS bf16_t* kp = Ks + (qi0 + 16 * kt + l15) * 72 + 8 * q4;
            const bf16x8 a0 = *(const LAS bf16x8*)kp, a1 = *(const LAS bf16x8*)(kp + 32);
            f32x4 z = {0.f, 0.f, 0.f, 0.f};
            z = MFMA16(a0, qf0, z); s[kt] = MFMA16(a1, qf1, z);
        }
        float mx = sink;
#pragma unroll
        for (int kt = 0; kt < 10; ++kt)
#pragma unroll
            for (int i = 0; i < 4; ++i) {
                const int rel = 16 * kt + 4 * q4 + i - l15;
                const bool valid = rel >= 1 && rel <= 128 && (blk > 0 || (qi0 + 16 * kt + 4 * q4 + i) >= 128);
                const float sv = valid ? s[kt][i] : -1e30f; s[kt][i] = sv; mx = fmaxf(mx, sv);
            }
        mx = fmaxf(mx, __shfl_xor(mx, 16)); mx = fmaxf(mx, __shfl_xor(mx, 32));
        float sum = 0.f;
#pragma unroll
        for (int kt = 0; kt < 10; ++kt)
#pragma unroll
            for (int i = 0; i < 4; ++i) { const float p = __expf(s[kt][i] - mx); s[kt][i] = p; sum += p; }
        sum += __shfl_xor(sum, 16); sum += __shfl_xor(sum, 32);
        const float inv = 1.0f / (sum + __expf(sink - mx));
        bf16x8 pb[5];
#pragma unroll
        for (int kp = 0; kp < 5; ++kp) pb[kp] = __builtin_bit_cast(bf16x8, pack8(s[2 * kp], s[2 * kp + 1]));
        f32x4 o[4];
#pragma unroll
        for (int dt = 0; dt < 4; ++dt) {
            o[dt] = (f32x4){0.f, 0.f, 0.f, 0.f};
#pragma unroll
            for (int kp = 0; kp < 5; ++kp) {
                const LAS bf16_t* vp = Vt + (dt * 16 + l15) * 280 + qi0 + 32 * kp + 4 * q4;
                const u32x2 lo = *(const LAS u32x2*)vp, hi = *(const LAS u32x2*)(vp + 16);
                u32x4 av; av.x = lo.x; av.y = lo.y; av.z = hi.x; av.w = hi.y;
                o[dt] = MFMA16(__builtin_bit_cast(bf16x8, av), pb[kp], o[dt]);
            }
        }
        bf16_t* op = ATT + (size_t)(tok0 + qi0 + l15) * 512 + h * 64 + 4 * q4;
#pragma unroll
        for (int dt = 0; dt < 4; ++dt) { u32x2 wv; wv.x = cvt_pk_bf16(o[dt].x * inv, o[dt].y * inv); wv.y = cvt_pk_bf16(o[dt].z * inv, o[dt].w * inv); *(u32x2*)(op + dt * 16) = wv; }
    }
    __syncthreads();
}

__device__ __forceinline__ void attn_sample_item(LAS unsigned char* ldsw, const bf16_t* Q, const bf16_t* Kb, const bf16_t* Vb, const float* sk, const float* sv, bf16_t* ATT, const float* sinks, int item, int lane) {
    const int b = item >> 3, h = item & 7, kvh = h >> 2, rowb = TP + b * 4;
    LAS float* qs = (LAS float*)ldsw;
    LAS float* ps = (LAS float*)(ldsw + 1024);
#pragma unroll
    for (int t = 0; t < 4; ++t) qs[t * 64 + lane] = bf2f(Q[(size_t)(rowb + t) * 512 + h * 64 + lane]);
    asm volatile("s_waitcnt lgkmcnt(0)" ::: "memory");
    float sc[3][4];
#pragma unroll
    for (int t = 0; t < 4; ++t) sc[2][t] = 0.f;
#pragma unroll
    for (int sl = 0; sl < 2; ++sl) {
        const int j = lane + 64 * sl; const float* kp = sk + ((size_t)(b * 128 + j) * 2 + kvh) * 64;
        float s0 = 0.f, s1 = 0.f, s2 = 0.f, s3 = 0.f;
#pragma unroll 1
        for (int c = 0; c < 16; c += 4) {
            const f32x4 ka = *(const f32x4*)(kp + 4 * c), kb4 = *(const f32x4*)(kp + 4 * c + 4), kc = *(const f32x4*)(kp + 4 * c + 8), kd = *(const f32x4*)(kp + 4 * c + 12);
#pragma unroll
            for (int cc = 0; cc < 4; ++cc) { const f32x4 k4 = cc == 0 ? ka : cc == 1 ? kb4 : cc == 2 ? kc : kd; const LAS float* qq = qs + 4 * (c + cc);
                const f32x4 q0 = *(const LAS f32x4*)(qq), q1 = *(const LAS f32x4*)(qq + 64), q2 = *(const LAS f32x4*)(qq + 128), q3 = *(const LAS f32x4*)(qq + 192);
                s0 += (k4.x * q0.x + k4.y * q0.y) + (k4.z * q0.z + k4.w * q0.w); s1 += (k4.x * q1.x + k4.y * q1.y) + (k4.z * q1.z + k4.w * q1.w);
                s2 += (k4.x * q2.x + k4.y * q2.y) + (k4.z * q2.z + k4.w * q2.w); s3 += (k4.x * q3.x + k4.y * q3.y) + (k4.z * q3.z + k4.w * q3.w); }
        }
        sc[sl][0] = s0; sc[sl][1] = s1; sc[sl][2] = s2; sc[sl][3] = s3;
        asm volatile("" ::: "memory");
    }
    if (lane < 4) { const bf16_t* kp = Kb + (size_t)(rowb + lane) * 128 + kvh * 64;
#pragma unroll 2
        for (int c = 0; c < 16; ++c) { const u32x2 kk = *(const u32x2*)(kp + 4 * c);
            const float k0 = __uint_as_float(kk.x << 16), k1 = __uint_as_float(kk.x & 0xffff0000u), k2 = __uint_as_float(kk.y << 16), k3 = __uint_as_float(kk.y & 0xffff0000u);
#pragma unroll
            for (int t = 0; t < 4; ++t) { const f32x4 q4 = *(const LAS f32x4*)(qs + t * 64 + 4 * c); sc[2][t] += (k0 * q4.x + k1 * q4.y) + (k2 * q4.z + k3 * q4.w); } }
    }
    const float sink = sinks[h];
    float den[4];
#pragma unroll
    for (int t = 0; t < 4; ++t) {
        float mx = sink; bool vd[3];
#pragma unroll
        for (int sl = 0; sl < 3; ++sl) { const int j = lane + 64 * sl; vd[sl] = (j >= t + 1) && (j <= t + 128) && (j < 132); if (vd[sl]) mx = fmaxf(mx, sc[sl][t]); }
        mx = wave_max(mx);
        float sum = 0.f;
#pragma unroll
        for (int sl = 0; sl < 3; ++sl) { const int j = lane + 64 * sl; const float p = vd[sl] ? __expf(sc[sl][t] - mx) : 0.f; sum += p; if (j < 132) ps[t * 132 + j] = p; }
        sum = wave_sum(sum);
        den[t] = sum + __expf(sink - mx);
    }
    asm volatile("s_waitcnt lgkmcnt(0)" ::: "memory");
    float o[4] = {0.f, 0.f, 0.f, 0.f};
    const float* vp = sv + ((size_t)(b * 128) * 2 + kvh) * 64 + lane;
#pragma unroll 4
    for (int j = 0; j < 128; ++j) { const float v = vp[(size_t)j * 128];
#pragma unroll
        for (int t = 0; t < 4; ++t) o[t] += ps[t * 132 + j] * v; }
#pragma unroll
    for (int j = 0; j < 4; ++j) { const float v = bf2f(Vb[(size_t)(rowb + j) * 128 + kvh * 64 + lane]);
#pragma unroll
        for (int t = 0; t < 4; ++t) o[t] += ps[t * 132 + 128 + j] * v; }
#pragma unroll
    for (int t = 0; t < 4; ++t) ATT[(size_t)(rowb + t) * 512 + h * 64 + lane] = (bf16_t)(cvt_pk_bf16(o[t] / den[t], 0.f) & 0xffffu);
    asm volatile("s_waitcnt lgkmcnt(0)" ::: "memory");
}

template <int T, bool SAMPLE>
__device__ __forceinline__ void conv_phase(LAS unsigned char* lds, const bf16_t* U, const float* state_conv, const float* cw, const float* cb, const float* lng, const float* lnb, bf16_t* CV, int it0, int nit, int stride, int tid) {
    if (it0 >= nit) return;
    const int cp = tid & 255, c0 = 2 * cp, th = __builtin_amdgcn_readfirstlane(tid >> 8), wv = __builtin_amdgcn_readfirstlane(tid >> 6), lane = tid & 63;
    float w0[31], w1[31];
#pragma unroll
    for (int j = 0; j < 31; ++j) { const f32x2 ww = *(const f32x2*)(cw + j * 512 + c0); w0[j] = ww.x; w1[j] = ww.y; }
    const f32x2 bias = *(const f32x2*)(cb + c0), gg = *(const f32x2*)(lng + c0), bb2 = *(const f32x2*)(lnb + c0);
    const unsigned* Uc = (const unsigned*)U + cp;
    const f32x2* Sc = (const f32x2*)state_conv + cp;
    unsigned* CVc = (unsigned*)CV + cp;
    LAS float* red = (LAS float*)(lds + CONV_RED_OFF);
    for (int item = it0; item < nit; item += stride) {
        int rowf, tl0 = 0, bs = 0;
        if (SAMPLE) { bs = item * 2 + th; rowf = TP + bs * 4; }
        else { rowf = item * 16 + th * 8; tl0 = rowf & 4095; }
        float a0[T], a1[T];
#pragma unroll
        for (int t = 0; t < T; ++t) { a0[t] = bias.x; a1[t] = bias.y; }
#pragma unroll
        for (int si = 0; si < T + 30; ++si) {
            float u0 = 0.f, u1 = 0.f;
            if (SAMPLE) {
                if (si < 30) { const f32x2 uu = Sc[(size_t)(bs * 30 + si) * 256]; u0 = uu.x; u1 = uu.y; }
                else { const unsigned uu = Uc[(size_t)(rowf + si - 30) * 256]; u0 = __uint_as_float(uu << 16); u1 = __uint_as_float(uu & 0xffff0000u); }
            } else {
                const bool ok = tl0 + si - 30 >= 0; const unsigned uu = Uc[(size_t)(ok ? rowf + si - 30 : rowf) * 256]; u0 = ok ? __uint_as_float(uu << 16) : 0.f; u1 = ok ? __uint_as_float(uu & 0xffff0000u) : 0.f;
            }
#pragma unroll
            for (int t = 0; t < T; ++t) { const int j = si - t; if (j >= 0 && j <= 30) { a0[t] += w0[j] * u0; a1[t] += w1[j] * u1; } }
            if ((si & 7) == 7) asm volatile("" ::: "memory");
        }
#pragma unroll
        for (int t = 0; t < T; ++t) {
            const float s1 = wave_sum(a0[t] + a1[t]), s2 = wave_sum(a0[t] * a0[t] + a1[t] * a1[t]);
            if (lane == 0) { red[wv * 2 * T + 2 * t] = s1; red[wv * 2 * T + 2 * t + 1] = s2; }
        }
        __syncthreads();
#pragma unroll
        for (int t = 0; t < T; ++t) {
            float s1 = 0.f, s2 = 0.f;
#pragma unroll
            for (int k = 0; k < 4; ++k) { s1 += red[(th * 4 + k) * 2 * T + 2 * t]; s2 += red[(th * 4 + k) * 2 * T + 2 * t + 1]; }
            const float mean = s1 * (1.0f / 512.0f), var = fmaxf(s2 * (1.0f / 512.0f) - mean * mean, 0.f), rstd = rsqrtf(var + 1e-5f);
            const float n0 = (a0[t] - mean) * rstd * gg.x + bb2.x, n1 = (a1[t] - mean) * rstd * gg.y + bb2.y;
            CVc[(size_t)(rowf + t) * 256] = cvt_pk_bf16(n0 * sigm(n0), n1 * sigm(n1));
        }
        __syncthreads();
    }
}
#ifndef MK_MULTI
#define MK_MULTI 1
#endif
__global__ void __launch_bounds__(512, 2) mega(Args a) {
    extern __shared__ __attribute__((aligned(16))) unsigned char lds_raw[];
    cg::grid_group grid = cg::this_grid();
    LAS unsigned char* lds = (LAS unsigned char*)lds_raw;
    const int tid = threadIdx.x, lane = tid & 63, wave = __builtin_amdgcn_readfirstlane(tid >> 6);
    const int G = gridDim.x, bid = blockIdx.x, gw = bid * 8 + wave, ngw = G * 8;
    unsigned char* ws = a.ws; float* out = a.out;
    float* mods = (float*)(ws + WS_MODS);
    bf16_t *Wi = (bf16_t*)(ws + WS_WIN), *Wao = (bf16_t*)(ws + WS_WAO), *Wco = (bf16_t*)(ws + WS_WCO), *Wo = (bf16_t*)(ws + WS_WOUT), *Wf1 = (bf16_t*)(ws + WS_WF1), *Wf2 = (bf16_t*)(ws + WS_WF2);
    bf16_t *H = (bf16_t*)(ws + WS_H), *Q = (bf16_t*)(ws + WS_Q), *Kb = (bf16_t*)(ws + WS_K), *Vb = (bf16_t*)(ws + WS_V), *U = (bf16_t*)(ws + WS_U), *GA = (bf16_t*)(ws + WS_GA), *GC = (bf16_t*)(ws + WS_GC);
    bf16_t *ATT = (bf16_t*)(ws + WS_ATT), *CV = (bf16_t*)(ws + WS_CV), *MM = (bf16_t*)(ws + WS_MM), *ACT = (bf16_t*)(ws + WS_ACT);
    const int lo = a.ph_lo, hi = a.ph_hi;
#ifndef P3SEL
#define P3SEL 15
#endif
#ifndef PHMASK
#define PHMASK 0x3ff
#endif
#define IN(k) (((PHMASK >> (k)) & 1) && lo <= (k) && (k) < hi)
#define SEAM(k) do { if (IN(k) && IN((k) + 1)) grid.sync(); } while (0)

    if (IN(0)) {
        for (int it = bid; it < 192; it += G) mods_item(lds, a.in[I_CP], a.in[I_CS], a.in[I_WADA], a.in[I_BADA], mods, it, tid);
        __syncthreads();
        LAS float* scr = (LAS float*)(lds + wave * 16384);
        constexpr int T_IN = 16 * 120, T_AO = 8 * 32, T_CO = 8 * 32, T_OUT = 16 * 32, T_F1 = 16 * 176, T_F2 = 44 * 32;
        for (int it = gw; it < T_IN + T_AO + T_CO + T_OUT + T_F1 + T_F2; it += ngw) {
            int r = it;
            if (r < T_IN) { transpose_item(a.in[I_WIN], D, NIN, Wi, 1, scr, r, lane); continue; } r -= T_IN;
            if (r < T_AO) { transpose_item(a.in[I_WAO], 512, D, Wao, 0, scr, r, lane); continue; } r -= T_AO;
            if (r < T_CO) { transpose_item(a.in[I_WCO], 512, D, Wco, 0, scr, r, lane); continue; } r -= T_CO;
            if (r < T_OUT) { transpose_item(a.in[I_WOUT], D, D, Wo, 0, scr, r, lane); continue; } r -= T_OUT;
            if (r < T_F1) { transpose_item(a.in[I_WF1], D, 2 * FF, Wf1, 2, scr, r, lane); continue; } r -= T_F1;
            transpose_item(a.in[I_WF2], FF, D, Wf2, 0, scr, r, lane);
        }
        const int gt = bid * 512 + tid, ngt = G * 512;
        for (int i = gt; i < 128 * 3968; i += ngt) { const int b = i / 3968, o = i % 3968;
            ((f32x4*)(out + O_KS + (size_t)b * 16384))[o] = ((const f32x4*)(a.in[I_SK] + (size_t)b * 16384 + 512))[o];
            ((f32x4*)(out + O_VS + (size_t)b * 16384))[o] = ((const f32x4*)(a.in[I_SV] + (size_t)b * 16384 + 512))[o]; }
        for (int i = gt; i < 128 * 3328; i += ngt) { const int b = i / 3328, o = i % 3328;
            ((f32x4*)(out + O_CS + (size_t)b * 15360))[o] = ((const f32x4*)(a.in[I_SC] + (size_t)b * 15360 + 2048))[o]; }
    }
    SEAM(0);
    if (IN(1)) rows_norm_mod(a.in[I_XP], a.in[I_XS], a.in[I_N1], mods, 0, H, gw, ngw, lane);
    SEAM(1);
    if (IN(2)) {
        __syncthreads();
        pg8::Gemm g{H, Wi, MT, NIN, D}; pg8::StaticOrder S; S.init(MT, NIN, G, bid);
        EpiIn E{Q, Kb, Vb, U, GA, GC, out};
        pg8::gemm_phase<EpiIn, pg8::StaticOrder>(lds, g, S, E, nullptr);
    }
    SEAM(2);
    if (IN(3)) {
        __syncthreads();
        if (P3SEL & 1) for (int it = bid; it < 512; it += G) attn_prompt_item(lds, Q, Kb, Vb, ATT, a.in[I_SINKS], it, tid);
        if (P3SEL & 2) for (int it = gw; it < 1024; it += ngw) attn_sample_item(lds + SATT_OFF + wave * 4096, Q, Kb, Vb, a.in[I_SK], a.in[I_SV], ATT, a.in[I_SINKS], it, lane);
        __syncthreads();
        if (P3SEL & 4) conv_phase<8, false>(lds, U, a.in[I_SC], a.in[I_CONVW], a.in[I_CONVB], a.in[I_LNG], a.in[I_LNB], CV, bid, 2048, G, tid);
        if (P3SEL & 8) conv_phase<4, true>(lds, U, a.in[I_SC], a.in[I_CONVW], a.in[I_CONVB], a.in[I_LNG], a.in[I_LNB], CV, G - 1 - bid, 64, G, tid);
    }
    SEAM(3);
    if (IN(4)) {
        __syncthreads();
        { pg8::Gemm g{ATT, Wao, MT, D, 512}; pg8::StaticOrder S; S.init(MT, D, G, bid); EpiGate<0> E{GA, MM}; pg8::gemm_phase<EpiGate<0>, pg8::StaticOrder>(lds, g, S, E, nullptr); }
        __syncthreads();
        { pg8::Gemm g{CV, Wco, MT, D, 512}; pg8::StaticOrder S; S.init(MT, D, G, bid); EpiGate<1> E{GC, MM}; pg8::gemm_phase<EpiGate<1>, pg8::StaticOrder>(lds, g, S, E, nullptr); }
    }
    SEAM(4);
    if (IN(5)) {
        __syncthreads();
        pg8::Gemm g{MM, Wo, MT, D, D}; pg8::StaticOrder S; S.init(MT, D, G, bid);
        EpiRes E{a.in[I_XP], a.in[I_XS], mods + 2 * 1024, out};
        pg8::gemm_phase<EpiRes, pg8::StaticOrder>(lds, g, S, E, nullptr);
    }
    SEAM(5);
    if (IN(6)) rows_norm_mod(out, out + (size_t)TP * D, a.in[I_N2], mods, 3, H, gw, ngw, lane);
    SEAM(6);
    if (IN(7)) {
        __syncthreads();
        pg8::Gemm g{H, Wf1, MT, 2 * FF, D}; pg8::StaticOrder S; S.init(MT, 2 * FF, G, bid);
        EpiSwi E{ACT};
        pg8::gemm_phase<EpiSwi, pg8::StaticOrder>(lds, g, S, E, nullptr);
    }
    SEAM(7);
    if (IN(8)) {
        __syncthreads();
        pg8::Gemm g{ACT, Wf2, MT, D, FF}; pg8::StaticOrder S; S.init(MT, D, G, bid);
        EpiRes E{out, out + (size_t)TP * D, mods + 5 * 1024, out};
        pg8::gemm_phase<EpiRes, pg8::StaticOrder>(lds, g, S, E, nullptr);
    }
    SEAM(8);
    if (IN(9)) rows_final(out, a.in[I_FNG], gw, ngw, lane);
#undef IN
#undef SEAM
}

extern "C" void kernel_launch(void* const* d_in, const int* in_sizes, int n_in, void* d_out, int out_size, void* d_ws, size_t ws_size, hipStream_t stream) {
    static int grid = 0;
    if (grid == 0) {
        int dev = 0, cus = 0, per_cu = 0;
        if (n_in != 23 || ws_size < WS_END) { fprintf(stderr, "kernel_launch: unexpected n_in %d / ws %zu\n", n_in, ws_size); grid = -1; return; }
        hipGetDevice(&dev);
        hipDeviceGetAttribute(&cus, hipDeviceAttributeMultiprocessorCount, dev);
        if (hipFuncSetAttribute((const void*)mega, hipFuncAttributeMaxDynamicSharedMemorySize, LDS_BYTES) != hipSuccess) { fprintf(stderr, "kernel_launch: hipFuncSetAttribute failed\n"); grid = -1; return; }
        if (hipOccupancyMaxActiveBlocksPerMultiprocessor(&per_cu, (const void*)mega, 512, LDS_BYTES) != hipSuccess || per_cu < 1) { fprintf(stderr, "kernel_launch: occupancy query says %d\n", per_cu); (void)hipGetLastError(); grid = -1; return; }
        grid = cus;
        fprintf(stderr, "kernel_launch: cus %d per_cu %d grid %d\n", cus, per_cu, grid);
    }
    if (grid < 0) return;
    Args a{};
    for (int i = 0; i < 23; ++i) a.in[i] = (const float*)d_in[i];
    a.out = (float*)d_out; a.ws = (unsigned char*)d_ws;
#if MK_MULTI
    for (int ph = 0; ph < NPH; ++ph) { a.ph_lo = ph; a.ph_hi = ph + 1; hipLaunchKernelGGL(mega, dim3(grid), dim3(512), LDS_BYTES, stream, a); }
#else
    a.ph_lo = 0; a.ph_hi = NPH;
    void* args[] = {&a};
    hipError_t e = hipLaunchCooperativeKernel((const void*)mega, dim3(grid), dim3(512), args, LDS_BYTES, stream);
    if (e != hipSuccess) fprintf(stderr, "cooperative launch failed: %s (grid %d)\n", hipGetErrorString(e), grid);
#endif
}
```

```cpp
#include <hip/hip_runtime.h>
#include <hip/hip_cooperative_groups.h>
#include <cstdio>
namespace cg = cooperative_groups;
namespace pg8 {
#define PG8_LAS __attribute__((address_space(3)))
typedef unsigned short bf16_t;
typedef short bf16x8 __attribute__((ext_vector_type(8)));
typedef float f32x4 __attribute__((ext_vector_type(4)));
typedef unsigned u32x4 __attribute__((ext_vector_type(4)));
constexpr int BM = 256, BK = 64, HALF = 128, HTB = HALF * BK * 2  , STAGE_BYTES = 8 * HTB, NXCD = 8, WGM = 8;

__host__ __device__ __forceinline__ int lds_byte(int r, int c) { const int st = (r >> 4) * 2 + (c >> 5), rr = r & 15, cc = c & 31, ob = rr * 64 + cc * 2; return st * 1024 + (ob ^ (((ob >> 9) & 1) << 5)); }
__host__ __device__ __forceinline__ void stage_rc(int b, int& R, int& C) { const int st = b / 1024, sb = b % 1024, swz = sb ^ (((sb >> 9) & 1) << 5); R = (st >> 1) * 16 + swz / 64; C = (st & 1) * 32 + (swz % 64) / 2; }
__host__ __device__ __forceinline__ int perm32(int rho) { const int n = rho >> 4, i = rho & 15; return 8 * (i >> 2) + 4 * n + (i & 3); }

struct Unit { int pm, pn, k0, nt, sel; };
struct Gemm { const bf16_t* A; const bf16_t* Bt; int M, N, K; const bf16_t* A2; const bf16_t* Bt2; };

struct StaticOrder {
    int nM, nN, nwg, G, c, ntk;
    __host__ __device__ void init(int M, int N, int K, int G_, int c_) { nM = M / BM; nN = N / BM; nwg = nM * nN; G = G_; c = c_; ntk = K / BK; }
    __host__ __device__ __forceinline__ bool next(int i, Unit& u) const {
        const long L = (long)i * G + c; if (L >= nwg) return false;
        int wgid = (int)L; { const int q = nwg / NXCD, r = nwg % NXCD, xcd = wgid % NXCD, off = wgid / NXCD; wgid = (xcd < r ? xcd * (q + 1) : r * (q + 1) + (xcd - r) * q) + off; }
        const int nig = WGM * nN, gid = wgid / nig, fm = gid * WGM, gsz = (nM - fm) < WGM ? (nM - fm) : WGM;
        u.pm = fm + ((wgid % nig) % gsz); u.pn = (wgid % nig) / gsz; u.k0 = 0; u.nt = ntk; u.sel = 0; return true;
    }
    __device__ __forceinline__ void a_ready(const Unit&) const {}
    __device__ __forceinline__ void done(const Unit&) const {}
};
typedef float f32x2_cv __attribute__((ext_vector_type(2)));
typedef __bf16 bf16x2_cv __attribute__((ext_vector_type(2)));
__device__ __forceinline__ unsigned cvt_pk_bf16(float lo, float hi) { const f32x2_cv v = {lo, hi}; return __builtin_bit_cast(unsigned, __builtin_convertvector(v, bf16x2_cv)); }
template <class Epi, class Sched, bool STAMP = false>
__device__ __forceinline__ void gemm_phase(PG8_LAS unsigned char* lds, const Gemm g, const Sched& S, const Epi& E, unsigned long long* stamps) {
    int tid_ = threadIdx.x; asm volatile("" : "+v"(tid_));
    const int tid = tid_, wid = __builtin_amdgcn_readfirstlane(tid >> 6), lane = tid & 63, wr = wid >> 2, wc = wid & 3, fr = lane & 15, fq = lane >> 4;
    const int K = g.K;
    int ts_lo = 0, ts_hi = 0, nts = 0; const unsigned long long rt_entry = STAMP ? (unsigned long long)wall_clock64() : 0ull;
#define PG8_STAMP() do { if (STAMP && wid == 0 && nts < 64) { const unsigned long long _c = (unsigned long long)clock64(); \
        ts_lo = (lane == nts) ? (int)(unsigned)_c : ts_lo; ts_hi = (lane == nts) ? (int)(unsigned)(_c >> 32) : ts_hi; ++nts; } } while (0)
    PG8_STAMP();
    unsigned voffA[2], voffB[2];
#pragma unroll
    for (int i = 0; i < 2; ++i) { int R, C; stage_rc(tid * 16 + i * 8192, R, C); const int Rb = Epi::PERM ? ((R & ~31) + perm32(R & 31)) : R;
        voffA[i] = (unsigned)(R * K + C) * 2u; voffB[i] = (unsigned)(Rb * K + C) * 2u; }
    const size_t kstep = (size_t)(BK * 2);
    const size_t hstep = (size_t)HALF * K * 2;
    const size_t tstep = 2 * hstep;
    const unsigned ldsw = (unsigned)wid * 1024u;
    const int aoff = lds_byte(wr * 64 + fr, fq * 8), boff = lds_byte(wc * 32 + fr, fq * 8);
#define PG8_SA(b, h) (((b) * 2 + (h)) * HTB)
#define PG8_SB(b, h) ((4 + (b) * 2 + (h)) * HTB)
#define PG8_STAGE(bufoff, gbase, voff) do { _Pragma("unroll") for (int _i = 0; _i < 2; ++_i) \
        __builtin_amdgcn_global_load_lds((const unsigned*)((const char*)(gbase) + (voff)[_i]), (PG8_LAS unsigned*)(lds + (bufoff) + ldsw + _i * 8192), 16, 0, 0); } while (0)
#define PG8_LDA(dst, b, h) do { _Pragma("unroll") for (int m = 0; m < 4; ++m) _Pragma("unroll") for (int k = 0; k < 2; ++k) dst[m][k] = *(const PG8_LAS bf16x8*)(lds + PG8_SA(b, h) + aoff + m * 2048 + k * 1024); } while (0)
#define PG8_LDB(dst, b, h) do { _Pragma("unroll") for (int n = 0; n < 2; ++n) _Pragma("unroll") for (int k = 0; k < 2; ++k) dst[n][k] = *(const PG8_LAS bf16x8*)(lds + PG8_SB(b, h) + boff + n * 2048 + k * 1024); } while (0)
#define PG8_MMA(ai, bj, At, Bt) do { __builtin_amdgcn_s_setprio(1); _Pragma("unroll") for (int m = 0; m < 4; ++m) _Pragma("unroll") for (int n = 0; n < 2; ++n) _Pragma("unroll") for (int k = 0; k < 2; ++k) \
        acc[ai][bj][m][n] = __builtin_amdgcn_mfma_f32_16x16x32_bf16(Bt[n][k], At[m][k], acc[ai][bj][m][n], 0, 0, 0); __builtin_amdgcn_s_setprio(0); } while (0)
#define PG8_WAIT_V(n) asm volatile("s_waitcnt vmcnt(" #n ")" ::: "memory")
#define PG8_WAIT_L(n) asm volatile("s_waitcnt lgkmcnt(" #n ")" ::: "memory")
#define PG8_BAR __builtin_amdgcn_s_barrier()
#define PG8_SCHED __builtin_amdgcn_sched_barrier(0)
    Unit cur, nxt; int ui = 0;
    if (!S.next(0, cur)) return;
    f32x4 acc[2][2][4][2];
#pragma unroll
    for (int a = 0; a < 2; ++a)
#pragma unroll
        for (int b = 0; b < 2; ++b)
#pragma unroll
            for (int m = 0; m < 4; ++m)
#pragma unroll
                for (int n = 0; n < 2; ++n) acc[a][b][m][n] = (f32x4){0.f, 0.f, 0.f, 0.f};
    bf16x8 At[4][2], B0[2][2], B1[2][2];
    const char* cA = (const char*)((cur.sel & 1) ? g.A2 : g.A) + (size_t)cur.pm * tstep + (size_t)cur.k0 * 2; const char* cB = (const char*)((cur.sel & 1) ? g.Bt2 : g.Bt) + (size_t)cur.pn * tstep + (size_t)cur.k0 * 2;
    S.a_ready(cur);
    PG8_STAGE(PG8_SB(0, 0), cB, voffB); PG8_STAGE(PG8_SA(0, 0), cA, voffA); PG8_STAGE(PG8_SB(0, 1), cB + hstep, voffB); PG8_STAGE(PG8_SA(0, 1), cA + hstep, voffA);
    if (wr == 1) PG8_BAR;
    PG8_WAIT_V(4); PG8_BAR;
    PG8_STAGE(PG8_SB(1, 0), cB + kstep, voffB); PG8_STAGE(PG8_SA(1, 0), cA + kstep, voffA); PG8_STAGE(PG8_SB(1, 1), cB + hstep + kstep, voffB);
    PG8_WAIT_V(6); PG8_BAR;
    PG8_STAMP();
    for (;;) {
        const bool has_next = S.next(ui + 1, nxt);
        const char* nA = has_next ? (const char*)((nxt.sel & 1) ? g.A2 : g.A) + (size_t)nxt.pm * tstep + (size_t)nxt.k0 * 2 : cA; const char* nB = has_next ? (const char*)((nxt.sel & 1) ? g.Bt2 : g.Bt) + (size_t)nxt.pn * tstep + (size_t)nxt.k0 * 2 : cB;
        const int nt = cur.nt;
        for (int t = 0; t < nt; t += 2) {
            const bool last = (t == nt - 2);
            const char* a1 = cA + (size_t)(t + 1) * kstep;
            const char* a2 = last ? nA : cA + (size_t)(t + 2) * kstep; const char* b2 = last ? nB : cB + (size_t)(t + 2) * kstep;
            const char* a3 = a2 + kstep; const char* b3 = b2 + kstep;
            if (last && has_next) S.a_ready(nxt);
            PG8_LDB(B0, 0, 0); PG8_SCHED; PG8_LDA(At, 0, 0); PG8_STAGE(PG8_SA(1, 1), a1 + hstep, voffA);
            PG8_WAIT_L(8); PG8_BAR; PG8_WAIT_L(0); PG8_MMA(0, 0, At, B0); PG8_BAR; PG8_SCHED;
            PG8_LDB(B1, 0, 1); PG8_STAGE(PG8_SB(0, 0), b2, voffB);
            PG8_BAR; PG8_WAIT_L(0); PG8_MMA(0, 1, At, B1); PG8_BAR;
            PG8_LDA(At, 0, 1); PG8_STAGE(PG8_SA(0, 0), a2, voffA);
            PG8_BAR; PG8_WAIT_L(0); PG8_MMA(1, 0, At, B0); PG8_BAR; PG8_SCHED;
            PG8_STAGE(PG8_SB(0, 1), b2 + hstep, voffB);
            PG8_WAIT_V(6); PG8_BAR; PG8_MMA(1, 1, At, B1); PG8_BAR;
            PG8_LDB(B0, 1, 0); PG8_SCHED; PG8_LDA(At, 1, 0); PG8_STAGE(PG8_SA(0, 1), a2 + hstep, voffA);
            PG8_WAIT_L(8); PG8_BAR; PG8_WAIT_L(0); PG8_MMA(0, 0, At, B0); PG8_BAR; PG8_SCHED;
            PG8_LDB(B1, 1, 1); PG8_STAGE(PG8_SB(1, 0), b3, voffB);
            PG8_BAR; PG8_WAIT_L(0); PG8_MMA(0, 1, At, B1); PG8_BAR;
            PG8_LDA(At, 1, 1); PG8_STAGE(PG8_SA(1, 0), a3, voffA);
            PG8_BAR; PG8_WAIT_L(0); PG8_MMA(1, 0, At, B0); PG8_BAR; PG8_SCHED;
            PG8_STAGE(PG8_SB(1, 1), b3 + hstep, voffB);
            PG8_WAIT_V(6); PG8_BAR; PG8_MMA(1, 1, At, B1); PG8_BAR;
        }
        PG8_STAMP();
        if constexpr (!Epi::AFTER_DRAIN) { E(acc, cur, wr, wc, fr, fq); S.done(cur); }
        PG8_STAMP();
        if (!has_next) break;
        if (!(Epi::CHAIN && (cur.sel & 2)))
#pragma unroll
        for (int a = 0; a < 2; ++a)
#pragma unroll
            for (int b = 0; b < 2; ++b)
#pragma unroll
                for (int m = 0; m < 4; ++m)
#pragma unroll
                    for (int n = 0; n < 2; ++n) acc[a][b][m][n] = (f32x4){0.f, 0.f, 0.f, 0.f};
        cur = nxt; cA = nA; cB = nB; ++ui;
    }
    PG8_WAIT_V(0);
    if (wr == 0) PG8_BAR;
    PG8_BAR;
    if constexpr (Epi::AFTER_DRAIN) { E.fused(acc, cur, wr, wc, fr, fq, lds, wid, lane); S.done(cur); }
    PG8_STAMP();
    if (STAMP && wid == 0) { stamps[lane] = lane < nts ? (((unsigned long long)(unsigned)ts_hi << 32) | (unsigned)ts_lo) : 0ull;
        if (lane == 62) stamps[62] = rt_entry; if (lane == 63) stamps[63] = (unsigned long long)wall_clock64(); }
#undef PG8_STAMP
#undef PG8_SA
#undef PG8_SB
#undef PG8_STAGE
#undef PG8_LDA
#undef PG8_LDB
#undef PG8_MMA
#undef PG8_WAIT_V
#undef PG8_WAIT_L
#undef PG8_BAR
#undef PG8_SCHED
}
}
using pg8::bf16_t; using pg8::bf16x8; using pg8::f32x4; using pg8::u32x4; using pg8::Unit; using pg8::cvt_pk_bf16;
#define LAS __attribute__((address_space(3)))
typedef unsigned u32x2 __attribute__((ext_vector_type(2)));
typedef float f32x2 __attribute__((ext_vector_type(2)));

constexpr int D = 1024, TP = 32768, TS = 512, MT = TP + TS, NIN = 3840, FF = 2816, NMOD = 6144;
constexpr size_t MiB = 1u << 20;
constexpr size_t WS_MODS = 1 * MiB, WS_WIN = 5 * MiB, WS_WAO = 13 * MiB, WS_WCO = 14 * MiB, WS_WOUT = 15 * MiB, WS_WF1 = 17 * MiB, WS_WF2 = 28 * MiB,
                 WS_H = 34 * MiB, WS_Q = 99 * MiB, WS_K = 132 * MiB, WS_V = 141 * MiB, WS_U = 150 * MiB, WS_GA = 183 * MiB, WS_GC = 248 * MiB,
                 WS_ATT = 313 * MiB, WS_CV = 346 * MiB, WS_MM = 379 * MiB, WS_ACT = 99 * MiB, WS_END = 444 * MiB;
constexpr size_t O_YS = 33554432, O_KP = 34078720, O_VP = 34209792, O_CP = 34340864, O_KS = 34463744, O_VS = 36560896, O_CS = 38658048;
constexpr int LDS_BYTES = 147456;
constexpr int NPH = 10;

__device__ __forceinline__ float bf2f(unsigned short b) { return __uint_as_float(((unsigned)b) << 16); }
__device__ __forceinline__ float sigm(float x) { return __builtin_amdgcn_rcpf(1.0f + __builtin_amdgcn_exp2f(x * -1.4426950408889634f)); }
__device__ __forceinline__ float wave_sum(float v) {
#pragma unroll
    for (int o = 1; o < 64; o <<= 1) v += __shfl_xor(v, o);
    return v;
}
__device__ __forceinline__ float wave_max(float v) {
#pragma unroll
    for (int o = 1; o < 64; o <<= 1) v = fmaxf(v, __shfl_xor(v, o));
    return v;
}
__device__ __forceinline__ int mod_row(int r) { return r < TP ? (r >> 12) : 8 + ((r - TP) >> 2); }
__device__ __forceinline__ void unpack8(const u32x4 w, float (&f)[8]) {
    f[0] = __uint_as_float(w.x << 16); f[1] = __uint_as_float(w.x & 0xffff0000u); f[2] = __uint_as_float(w.y << 16); f[3] = __uint_as_float(w.y & 0xffff0000u);
    f[4] = __uint_as_float(w.z << 16); f[5] = __uint_as_float(w.z & 0xffff0000u); f[6] = __uint_as_float(w.w << 16); f[7] = __uint_as_float(w.w & 0xffff0000u);
}

struct Args { const float* in[23]; float* out; unsigned char* ws; int ph_lo, ph_hi; };
enum { I_XP = 0, I_XS, I_SK, I_SV, I_SC, I_CP, I_CS, I_N1, I_N2, I_WADA, I_BADA, I_WIN, I_SINKS, I_WAO, I_CONVW, I_CONVB, I_LNG, I_LNB, I_WCO, I_WOUT, I_WF1, I_WF2, I_FNG };

__device__ __forceinline__ void transpose_item(const float* W, int K, int N, bf16_t* WT, int which, LAS float* scr, int item, int lane) {
    const int nblk = N / 32, kb = item / nblk, nb = item % nblk, k0 = 64 * kb, n0 = 32 * nb;
    { f32x4 v[8]; const int kq = lane >> 3, n4 = (lane & 7) * 4;
#pragma unroll
      for (int i = 0; i < 8; ++i) v[i] = *(const f32x4*)(W + (size_t)(k0 + 8 * i + kq) * N + n0 + n4);
#pragma unroll
      for (int i = 0; i < 8; ++i) { LAS float* d = scr + (8 * i + kq) * 33 + n4; d[0] = v[i].x; d[1] = v[i].y; d[2] = v[i].z; d[3] = v[i].w; } }
    asm volatile("s_waitcnt lgkmcnt(0)" ::: "memory");
    int drow = n0;
    if (which == 1) { if (n0 >= 768 && n0 < 1280) { const int ch = n0 - 768; drow = 768 + 256 * (ch >> 7) + (ch & 127); } else if (n0 >= 1280 && n0 < 1792) { const int ch = n0 - 1280; drow = 768 + 256 * (ch >> 7) + 128 + (ch & 127); } }
    else if (which == 2) { if (n0 < FF) drow = 256 * (n0 >> 7) + (n0 & 127); else { const int ch = n0 - FF; drow = 256 * (ch >> 7) + 128 + (ch & 127); } }
    const int c = lane & 7;
#pragma unroll
    for (int j = 0; j < 4; ++j) { const int n = (lane >> 3) + 8 * j; const LAS float* s = scr + (8 * c) * 33 + n;
        u32x4 o; o.x = cvt_pk_bf16(s[0 * 33], s[1 * 33]); o.y = cvt_pk_bf16(s[2 * 33], s[3 * 33]); o.z = cvt_pk_bf16(s[4 * 33], s[5 * 33]); o.w = cvt_pk_bf16(s[6 * 33], s[7 * 33]);
        *(u32x4*)(WT + (size_t)(drow + n) * K + k0 + 8 * c) = o; }
    asm volatile("s_waitcnt lgkmcnt(0)" ::: "memory");
}

__device__ __forceinline__ void mods_item(LAS unsigned char* lds, const float* cp, const float* cs, const float* wada, const float* bada, float* mods, int item, int tid) {
    const int rg = item / 24, cb = item % 24;
    LAS float* sc = (LAS float*)lds;
    LAS float* red = (LAS float*)(lds + 81920);
    { float cvv[34];
#pragma unroll
      for (int i = 0; i < 34; ++i) { const int row = rg * 17 + (i >> 1); const float* src = row < 8 ? cp + row * 1024 : cs + (row - 8) * 1024; cvv[i] = src[tid + 512 * (i & 1)]; }
#pragma unroll
      for (int i = 0; i < 34; ++i) sc[(tid + 512 * (i & 1)) * 20 + (i >> 1)] = cvv[i] * sigm(cvv[i]); }
    __syncthreads();
    const int cq = tid & 63, ks = __builtin_amdgcn_readfirstlane(tid >> 6), col = cb * 256 + 4 * cq;
    f32x2 a01[17], a23[17];
#pragma unroll
    for (int r = 0; r < 17; ++r) { a01[r] = (f32x2){0.f, 0.f}; a23[r] = (f32x2){0.f, 0.f}; }
    const float* wp = wada + (size_t)(ks * 128) * NMOD + col;
#pragma unroll 8
    for (int k = 0; k < 128; ++k) {
        const f32x4 w4 = *(const f32x4*)(wp + (size_t)k * NMOD); const f32x2 wl = {w4.x, w4.y}, wh = {w4.z, w4.w};
        const LAS float* s = sc + (ks * 128 + k) * 20;
        const f32x4 s0 = *(const LAS f32x4*)s, s1 = *(const LAS f32x4*)(s + 4), s2 = *(const LAS f32x4*)(s + 8), s3 = *(const LAS f32x4*)(s + 12); const float s4 = s[16];
        const float sv[17] = {s0.x, s0.y, s0.z, s0.w, s1.x, s1.y, s1.z, s1.w, s2.x, s2.y, s2.z, s2.w, s3.x, s3.y, s3.z, s3.w, s4};
#pragma unroll
        for (int r = 0; r < 17; ++r) { const f32x2 sp = {sv[r], sv[r]}; a01[r] += sp * wl; a23[r] += sp * wh; }
    }
    __syncthreads();
    LAS f32x4* red4 = (LAS f32x4*)lds;
#pragma unroll
    for (int half = 4; half >= 1; half >>= 1) {
        if (ks >= half && ks < 2 * half) {
#pragma unroll
            for (int r = 0; r < 17; ++r) red4[((ks - half) * 17 + r) * 64 + cq] = (f32x4){a01[r].x, a01[r].y, a23[r].x, a23[r].y};
        }
        __syncthreads();
        if (ks < half) {
#pragma unroll
            for (int r = 0; r < 17; ++r) { const f32x4 p = red4[(ks * 17 + r) * 64 + cq]; a01[r] += (f32x2){p.x, p.y}; a23[r] += (f32x2){p.z, p.w}; }
        }
        __syncthreads();
    }
    if (ks == 0) { const f32x4 bb = *(const f32x4*)(bada + col);
#pragma unroll
        for (int r = 0; r < 17; ++r) *(f32x4*)(mods + (size_t)(rg * 17 + r) * NMOD + col) = (f32x4){a01[r].x, a01[r].y, a23[r].x, a23[r].y} + bb; }
    __syncthreads();
}

#define NT_ST(val, ptr) (*(ptr) = (val))
__device__ __forceinline__ void rows_norm_mod(const float* basep, const float* bases, const float* ng, const float* mods, int chunk_sh, bf16_t* H, float* copy_out, int gw, int ngw, int lane) {
    f32x4 v[4][4], nx[4][4];
    if (gw < MT / 4) { const int r0 = gw * 4; const float* xr = (r0 < TP ? basep + (size_t)r0 * D : bases + (size_t)(r0 - TP) * D) + 4 * lane;
#pragma unroll
        for (int rr = 0; rr < 4; ++rr)
#pragma unroll
            for (int j = 0; j < 4; ++j) nx[rr][j] = *(const f32x4*)(xr + (size_t)rr * D + 256 * j); }
    for (int wi = gw; wi < MT / 4; wi += ngw) {
        const int r0 = wi * 4; const float* mp = mods + (size_t)mod_row(r0) * NMOD + chunk_sh * 1024;
#pragma unroll
        for (int rr = 0; rr < 4; ++rr)
#pragma unroll
            for (int j = 0; j < 4; ++j) v[rr][j] = nx[rr][j];
        if (wi + ngw < MT / 4) { const int r1 = (wi + ngw) * 4; const float* xr = (r1 < TP ? basep + (size_t)r1 * D : bases + (size_t)(r1 - TP) * D) + 4 * lane;
#pragma unroll
            for (int rr = 0; rr < 4; ++rr)
#pragma unroll
                for (int j = 0; j < 4; ++j) nx[rr][j] = *(const f32x4*)(xr + (size_t)rr * D + 256 * j); }
        f32x4 gm[4], sh[4];
#pragma unroll
        for (int j = 0; j < 4; ++j) { const int c = 4 * lane + 256 * j; const f32x4 g = *(const f32x4*)(ng + c), s = *(const f32x4*)(mp + 1024 + c); gm[j] = g * (s + 1.0f); sh[j] = *(const f32x4*)(mp + c); }
#pragma unroll
        for (int rr = 0; rr < 4; ++rr) {
            const int r = r0 + rr; float ss = 0.f;
#pragma unroll
            for (int j = 0; j < 4; ++j) ss += (v[rr][j].x * v[rr][j].x + v[rr][j].y * v[rr][j].y) + (v[rr][j].z * v[rr][j].z + v[rr][j].w * v[rr][j].w);
            if (copy_out != nullptr && r >= TP) {
#pragma unroll
                for (int j = 0; j < 4; ++j) *(f32x4*)(copy_out + (size_t)r * D + 4 * lane + 256 * j) = v[rr][j]; }
            const float rinv = rsqrtf(wave_sum(ss) * (1.0f / D) + 1e-6f);
#pragma unroll
            for (int j = 0; j < 4; ++j) { const f32x4 o = v[rr][j] * rinv * gm[j] + sh[j]; u32x2 w; w.x = cvt_pk_bf16(o.x, o.y); w.y = cvt_pk_bf16(o.z, o.w);
                NT_ST(w, (u32x2*)(H + (size_t)r * D + 4 * lane + 256 * j)); }
        }
    }
}
__device__ __forceinline__ void rows_final(const float* in, float* out, const float* g, int gw, int ngw, int lane) {
    f32x4 gm[4];
#pragma unroll
    for (int j = 0; j < 4; ++j) gm[j] = *(const f32x4*)(g + 4 * lane + 256 * j);
    for (int wi = gw; wi < MT / 4; wi += ngw) {
        const float* xr = in + (size_t)wi * 4 * D + 4 * lane; float* orow = out + (size_t)wi * 4 * D + 4 * lane;
        f32x4 v[4][4];
#pragma unroll
        for (int rr = 0; rr < 4; ++rr)
#pragma unroll
            for (int j = 0; j < 4; ++j) v[rr][j] = (*(const f32x4*)(xr + (size_t)rr * D + 256 * j));
#pragma unroll
        for (int rr = 0; rr < 4; ++rr) {
            float ss = 0.f;
#pragma unroll
            for (int j = 0; j < 4; ++j) ss += (v[rr][j].x * v[rr][j].x + v[rr][j].y * v[rr][j].y) + (v[rr][j].z * v[rr][j].z + v[rr][j].w * v[rr][j].w);
            const float rinv = rsqrtf(wave_sum(ss) * (1.0f / D) + 1e-6f);
#pragma unroll
            for (int j = 0; j < 4; ++j) NT_ST(v[rr][j] * rinv * gm[j], (f32x4*)(orow + (size_t)rr * D + 256 * j));
        }
    }
}
__device__ __forceinline__ u32x4 pack8(const f32x4 a, const f32x4 b) { u32x4 w; w.x = cvt_pk_bf16(a.x, a.y); w.y = cvt_pk_bf16(a.z, a.w); w.z = cvt_pk_bf16(b.x, b.y); w.w = cvt_pk_bf16(b.z, b.w); return w; }

struct EpiIn {
    static constexpr bool PERM = true, AFTER_DRAIN = false, CHAIN = false;
    bf16_t *Q, *K, *V, *U, *GA, *GC; float* out;
    __device__ __forceinline__ void operator()(f32x4 (&acc)[2][2][4][2], const Unit& u, int wr, int wc, int fr, int fq) const {
        const int rowb = u.pm * 256 + wr * 64 + fr, cl = wc * 32 + 8 * fq, pn = u.pn;
        const bool sample = u.pm >= 128;
        if (pn <= 2) {
            const bool do_rope = (wc & 1) == 0;
            constexpr float INV_H[8] = {0.1591796875f, 0.0308837890625f, 0.0059814453125f, 0.00115966796875f, 0.000225067138671875f, 4.363059997558594e-05f, 8.463859558105469e-06f, 1.642853021621704e-06f};
            constexpr float INV_L[8] = {-2.474440771038644e-05f, -2.002565815928392e-05f, 3.7404001886898186e-06f, 9.956725079973694e-07f, 1.1940367805607366e-08f, 1.7352817849314306e-08f, 4.712501500137023e-10f, -1.4267588221983374e-09f};
#pragma unroll
            for (int ai = 0; ai < 2; ++ai)
#pragma unroll
                for (int m = 0; m < 4; ++m) {
                    const int r = rowb + ai * 128 + m * 16;
                    const int pos = sample ? 16384 + ((r - TP) & 3) : (r & 4095);
                    f32x4 v[2][2];
#pragma unroll
                    for (int bj = 0; bj < 2; ++bj)
#pragma unroll
                        for (int n = 0; n < 2; ++n) v[bj][n] = acc[ai][bj][m][n];
                    if (do_rope) {
#pragma unroll
                        for (int n = 0; n < 2; ++n)
#pragma unroll
                            for (int i = 0; i < 4; ++i) {
                                const float ph = (float)pos * INV_H[4 * n + i];
                                const float fx = (ph - __builtin_floorf(ph)) + (float)pos * INV_L[4 * n + i];
                                const float cs = __builtin_amdgcn_cosf(fx), sn = __builtin_amdgcn_sinf(fx);
#pragma unroll
                                for (int bj = 0; bj < 2; ++bj) {
                                    if (bj == 1 && pn == 2) continue;
                                    const float mine = v[bj][n][i], other = __shfl_xor(mine, 16);
                                    const float rot = (fq == 0) ? (mine * cs - other * sn) : (mine * cs + other * sn);
                                    v[bj][n][i] = (fq < 2) ? rot : mine;
                                }
                            }
                    }
                    if (pn < 2) {
#pragma unroll
                        for (int bj = 0; bj < 2; ++bj) NT_ST((u32x4)(pack8(v[bj][0] * 0.125f, v[bj][1] * 0.125f)), (u32x4*)(Q + (size_t)r * 512 + pn * 256 + bj * 128 + cl));
                    } else {
                        NT_ST((u32x4)(pack8(v[0][0], v[0][1])), (u32x4*)(K + (size_t)r * 128 + cl));
                        NT_ST((u32x4)(pack8(v[1][0], v[1][1])), (u32x4*)(V + (size_t)r * 128 + cl));
                        if (!sample) { const int t = r & 4095;
                            if (t >= 3968) { const size_t o = ((size_t)((r >> 12) * 128 + t - 3968)) * 128 + cl;
                                NT_ST((f32x4)(v[0][0]), (f32x4*)(out + O_KP + o)); NT_ST((f32x4)(v[0][1]), (f32x4*)(out + O_KP + o + 4)); NT_ST((f32x4)(v[1][0]), (f32x4*)(out + O_VP + o)); NT_ST((f32x4)(v[1][1]), (f32x4*)(out + O_VP + o + 4)); }
                        } else { const int bs = (r - TP) >> 2, t = (r - TP) & 3; const size_t o = ((size_t)(bs * 128 + 124 + t)) * 128 + cl;
                            NT_ST((f32x4)(v[0][0]), (f32x4*)(out + O_KS + o)); NT_ST((f32x4)(v[0][1]), (f32x4*)(out + O_KS + o + 4)); NT_ST((f32x4)(v[1][0]), (f32x4*)(out + O_VS + o)); NT_ST((f32x4)(v[1][1]), (f32x4*)(out + O_VS + o + 4)); }
                    }
                }
        } else if (pn <= 6) {
            const int chb = 128 * (pn - 3) + cl;
#pragma unroll
            for (int ai = 0; ai < 2; ++ai)
#pragma unroll
                for (int m = 0; m < 4; ++m) {
                    const int r = rowb + ai * 128 + m * 16;
                    f32x4 uu[2];
#pragma unroll
                    for (int n = 0; n < 2; ++n)
#pragma unroll
                        for (int i = 0; i < 4; ++i) uu[n][i] = acc[ai][0][m][n][i] * sigm(acc[ai][1][m][n][i]);
                    NT_ST((u32x4)(pack8(uu[0], uu[1])), (u32x4*)(U + (size_t)r * 512 + chb));
                    if (!sample) { const int t = r & 4095;
                        if (t >= 4066) { const size_t o = ((size_t)((r >> 12) * 30 + t - 4066)) * 512 + chb; NT_ST((f32x4)(uu[0]), (f32x4*)(out + O_CP + o)); NT_ST((f32x4)(uu[1]), (f32x4*)(out + O_CP + o + 4)); }
                    } else { const int bs = (r - TP) >> 2, t = (r - TP) & 3; const size_t o = ((size_t)(bs * 30 + 26 + t)) * 512 + chb; NT_ST((f32x4)(uu[0]), (f32x4*)(out + O_CS + o)); NT_ST((f32x4)(uu[1]), (f32x4*)(out + O_CS + o + 4)); }
                }
        } else {
            bf16_t* G = pn < 11 ? GA : GC; const int cb = 256 * ((pn - 7) & 3) + cl;
#pragma unroll
            for (int ai = 0; ai < 2; ++ai)
#pragma unroll
                for (int m = 0; m < 4; ++m) {
                    const int r = rowb + ai * 128 + m * 16;
#pragma unroll
                    for (int bj = 0; bj < 2; ++bj) { f32x4 a = acc[ai][bj][m][0], b = acc[ai][bj][m][1];
#pragma unroll
                        for (int i = 0; i < 4; ++i) { a[i] = sigm(a[i]); b[i] = sigm(b[i]); }
                        NT_ST((u32x4)(pack8(a, b)), (u32x4*)(G + (size_t)r * D + cb + bj * 128)); }
                }
        }
    }
};

template <int MODE> struct EpiGate {
    static constexpr bool PERM = true, AFTER_DRAIN = false, CHAIN = false;
    const bf16_t* G; bf16_t* MM;
    __device__ __forceinline__ void operator()(f32x4 (&acc)[2][2][4][2], const Unit& u, int wr, int wc, int fr, int fq) const {
        const int rowb = u.pm * 256 + wr * 64 + fr, cb = u.pn * 256 + wc * 32 + 8 * fq;
#pragma unroll
        for (int ai = 0; ai < 2; ++ai)
#pragma unroll
            for (int m = 0; m < 4; ++m) {
                const size_t ro = (size_t)(rowb + ai * 128 + m * 16) * D + cb;
#pragma unroll
                for (int bj = 0; bj < 2; ++bj) {
                    float g[8]; unpack8(*(const u32x4*)(G + ro + bj * 128), g);
                    f32x4 a = acc[ai][bj][m][0], b = acc[ai][bj][m][1];
                    a.x *= g[0]; a.y *= g[1]; a.z *= g[2]; a.w *= g[3]; b.x *= g[4]; b.y *= g[5]; b.z *= g[6]; b.w *= g[7];
                    if (MODE == 1) { float p[8]; unpack8(*(const u32x4*)(MM + ro + bj * 128), p); a.x += p[0]; a.y += p[1]; a.z += p[2]; a.w += p[3]; b.x += p[4]; b.y += p[5]; b.z += p[6]; b.w += p[7]; }
                    NT_ST((u32x4)(pack8(a, b)), (u32x4*)(MM + ro + bj * 128));
                }
            }
    }
};

struct MergeOrder {
    pg8::StaticOrder P;
    __device__ __forceinline__ void init(int G_, int c_) { P.init(TP, D, 512, G_, c_); }
    __device__ __forceinline__ bool next(int i, Unit& u) const { const bool ok = P.next(i >> 1, u); u.sel = (i & 1) ? 1 : 2; return ok; }
    __device__ __forceinline__ void a_ready(const Unit&) const {}
    __device__ __forceinline__ void done(const Unit&) const {}
};
struct SampleHalfOrder {
    int G, c;
    __device__ __forceinline__ void init(int G_, int c_) { G = G_; c = c_; }
    __device__ __forceinline__ bool next(int i, Unit& u) const { const int h = i * G + c, tile = h >> 1; u.pm = 128 + (tile >> 2); u.pn = tile & 3; u.k0 = 0; u.nt = 8; u.sel = h & 1; return h < 16; }
    __device__ __forceinline__ void a_ready(const Unit&) const {}
    __device__ __forceinline__ void done(const Unit&) const {}
};
struct EpiHalf {
    static constexpr bool PERM = true, AFTER_DRAIN = false, CHAIN = false;
    const bf16_t* GA; const bf16_t* GC; bf16_t* MM; bf16_t* PBv;
    __device__ __forceinline__ void operator()(f32x4 (&acc)[2][2][4][2], const Unit& u, int wr, int wc, int fr, int fq) const {
        const int rowb = u.pm * 256 + wr * 64 + fr, cb = u.pn * 256 + wc * 32 + 8 * fq;
        const bf16_t* Gt = (u.sel & 1) ? GC : GA; bf16_t* dst = (u.sel & 1) ? PBv : MM;
#pragma unroll
        for (int ai = 0; ai < 2; ++ai) {
            u32x4 wg[4][2];
#pragma unroll
            for (int m = 0; m < 4; ++m)
#pragma unroll
                for (int bj = 0; bj < 2; ++bj) wg[m][bj] = *(const u32x4*)(Gt + (size_t)(rowb + ai * 128 + m * 16) * D + cb + bj * 128);
#pragma unroll
            for (int m = 0; m < 4; ++m)
#pragma unroll
                for (int bj = 0; bj < 2; ++bj) {
                    float gg[8]; unpack8(wg[m][bj], gg);
                    f32x4 a = acc[ai][bj][m][0], b = acc[ai][bj][m][1];
                    a.x *= gg[0]; a.y *= gg[1]; a.z *= gg[2]; a.w *= gg[3]; b.x *= gg[4]; b.y *= gg[5]; b.z *= gg[6]; b.w *= gg[7];
                    *(u32x4*)(dst + (size_t)(rowb + ai * 128 + m * 16) * D + cb + bj * 128) = pack8(a, b);
                }
        }
    }
};
struct EpiMerge {
    static constexpr bool PERM = true, AFTER_DRAIN = false, CHAIN = true;
    const bf16_t* GA; const bf16_t* GC; bf16_t* MM;
    __device__ __forceinline__ void operator()(f32x4 (&acc)[2][2][4][2], const Unit& u, int wr, int wc, int fr, int fq) const {
        const int rowb = u.pm * 256 + wr * 64 + fr, cb = u.pn * 256 + wc * 32 + 8 * fq;
        if ((u.sel & 1) == 0) {
#pragma unroll
            for (int ai = 0; ai < 2; ++ai) {
                u32x4 wa[4][2], wc_[4][2];
#pragma unroll
                for (int m = 0; m < 4; ++m)
#pragma unroll
                    for (int bj = 0; bj < 2; ++bj) { const size_t ro = (size_t)(rowb + ai * 128 + m * 16) * D + cb + bj * 128; wa[m][bj] = *(const u32x4*)(GA + ro); wc_[m][bj] = *(const u32x4*)(GC + ro); }
#pragma unroll
                for (int m = 0; m < 4; ++m)
#pragma unroll
                    for (int bj = 0; bj < 2; ++bj) {
                        float ga[8], gc[8]; unpack8(wa[m][bj], ga); unpack8(wc_[m][bj], gc);
#pragma unroll
                        for (int i = 0; i < 4; ++i) { acc[ai][bj][m][0][i] *= ga[i] * __builtin_amdgcn_rcpf(gc[i]); acc[ai][bj][m][1][i] *= ga[4 + i] * __builtin_amdgcn_rcpf(gc[4 + i]); }
                    }
            }
        } else {
#pragma unroll
            for (int ai = 0; ai < 2; ++ai) {
                u32x4 wc_[4][2];
#pragma unroll
                for (int m = 0; m < 4; ++m)
#pragma unroll
                    for (int bj = 0; bj < 2; ++bj) wc_[m][bj] = *(const u32x4*)(GC + (size_t)(rowb + ai * 128 + m * 16) * D + cb + bj * 128);
#pragma unroll
                for (int m = 0; m < 4; ++m)
#pragma unroll
                    for (int bj = 0; bj < 2; ++bj) {
                        float gc[8]; unpack8(wc_[m][bj], gc);
                        f32x4 a = acc[ai][bj][m][0], b = acc[ai][bj][m][1];
                        a.x *= gc[0]; a.y *= gc[1]; a.z *= gc[2]; a.w *= gc[3]; b.x *= gc[4]; b.y *= gc[5]; b.z *= gc[6]; b.w *= gc[7];
                        *(u32x4*)(MM + (size_t)(rowb + ai * 128 + m * 16) * D + cb + bj * 128) = pack8(a, b);
                    }
            }
        }
    }
};
struct EpiRes {
    static constexpr bool PERM = false, AFTER_DRAIN = false, CHAIN = false;
    const float* basep; const float* gate; float* out;
    __device__ __forceinline__ void operator()(f32x4 (&acc)[2][2][4][2], const Unit& u, int wr, int wc, int fr, int fq) const {
        const int rowb = u.pm * 256 + wr * 64 + fr, cb = u.pn * 256 + wc * 32 + 4 * fq;
        if (u.pm < 128) {
            const float* gr = gate + (size_t)(u.pm >> 4) * NMOD + cb;
            f32x4 gv[2][2];
#pragma unroll
            for (int bj = 0; bj < 2; ++bj)
#pragma unroll
                for (int n = 0; n < 2; ++n) gv[bj][n] = *(const f32x4*)(gr + bj * 128 + n * 16);
#pragma unroll
            for (int ai = 0; ai < 2; ++ai) {
                f32x4 bs[4][2][2];
#pragma unroll
                for (int m = 0; m < 4; ++m)
#pragma unroll
                    for (int bj = 0; bj < 2; ++bj)
#pragma unroll
                        for (int n = 0; n < 2; ++n) bs[m][bj][n] = *(const f32x4*)(basep + (size_t)(rowb + ai * 128 + m * 16) * D + cb + bj * 128 + n * 16);
#pragma unroll
                for (int m = 0; m < 4; ++m)
#pragma unroll
                    for (int bj = 0; bj < 2; ++bj)
#pragma unroll
                        for (int n = 0; n < 2; ++n) *(f32x4*)(out + (size_t)(rowb + ai * 128 + m * 16) * D + cb + bj * 128 + n * 16) = bs[m][bj][n] + gv[bj][n] * acc[ai][bj][m][n];
            }
        } else {
#pragma unroll
            for (int ai = 0; ai < 2; ++ai) {
                f32x4 gs[4][2][2];
#pragma unroll
                for (int m = 0; m < 4; ++m) { const float* gr = gate + (size_t)mod_row(rowb + ai * 128 + m * 16) * NMOD + cb;
#pragma unroll
                    for (int bj = 0; bj < 2; ++bj)
#pragma unroll
                        for (int n = 0; n < 2; ++n) gs[m][bj][n] = *(const f32x4*)(gr + bj * 128 + n * 16); }
#pragma unroll
                for (int m = 0; m < 4; ++m) { float* orow = out + (size_t)(rowb + ai * 128 + m * 16) * D + cb;
#pragma unroll
                    for (int bj = 0; bj < 2; ++bj)
#pragma unroll
                        for (int n = 0; n < 2; ++n) { const int o = bj * 128 + n * 16; const f32x4 v = gs[m][bj][n] * acc[ai][bj][m][n];
                            unsafeAtomicAdd(orow + o, v.x); unsafeAtomicAdd(orow + o + 1, v.y); unsafeAtomicAdd(orow + o + 2, v.z); unsafeAtomicAdd(orow + o + 3, v.w); } }
            }
        }
    }
};
template <int DUAL> struct TailSplitOrder {
    pg8::StaticOrder P; int G, c, S, ntk;
    __device__ __forceinline__ void init(int K, int S_, int G_, int c_) { P.init(TP, D, K, G_, c_); G = G_; c = c_; S = S_; ntk = K / 64; }
    __device__ __forceinline__ bool next(int i, Unit& u) const {
        const int L = i * G + c; const bool isp = L < 512;
        Unit p; const bool okp = P.next(i, p);
        const int ST = DUAL ? 2 * S : S;
        const int idx = L - 512, tile = idx / ST, sl = idx - tile * ST, ns = ntk / S, half = sl >= S ? 1 : 0, sk = sl - half * S;
        u.pm = isp ? p.pm : 128 + (tile >> 2); u.pn = isp ? p.pn : (tile & 3); u.nt = isp ? ntk : ns; u.k0 = isp ? 0 : sk * ns * 64; u.sel = isp ? 0 : half;
        return isp ? okp : (idx < 8 * ST);
    }
    __device__ __forceinline__ void a_ready(const Unit&) const {}
    __device__ __forceinline__ void done(const Unit&) const {}
};

struct EpiSwi {
    static constexpr bool PERM = true, AFTER_DRAIN = false, CHAIN = false;
    bf16_t* ACT;
    __device__ __forceinline__ void operator()(f32x4 (&acc)[2][2][4][2], const Unit& u, int wr, int wc, int fr, int fq) const {
        const int rowb = u.pm * 256 + wr * 64 + fr, cb = u.pn * 128 + wc * 32 + 8 * fq;
#pragma unroll
        for (int ai = 0; ai < 2; ++ai)
#pragma unroll
            for (int m = 0; m < 4; ++m) {
                f32x4 uu[2];
#pragma unroll
                for (int n = 0; n < 2; ++n)
#pragma unroll
                    for (int i = 0; i < 4; ++i) { const float g = acc[ai][0][m][n][i]; uu[n][i] = g * sigm(g) * acc[ai][1][m][n][i]; }
                NT_ST((u32x4)(pack8(uu[0], uu[1])), (u32x4*)(ACT + (size_t)(rowb + ai * 128 + m * 16) * FF + cb));
            }
    }
};
#define MFMA16(a, b, c) __builtin_amdgcn_mfma_f32_16x16x32_bf16((a), (b), (c), 0, 0, 0)
constexpr int ATT_VT_OFF = 39168, SATT_OFF = 77824, CONV_RED_OFF = 110592;
__device__ __forceinline__ void attn_prompt_item(LAS unsigned char* lds, const bf16_t* Q, const bf16_t* Kb, const bf16_t* Vb, bf16_t* ATT, const float* sinks, int item, int tid) {
    const int b = item >> 6, blk = (item >> 1) & 31, kvh = item & 1;
    const int tok0 = b * 4096 + blk * 128;
    LAS bf16_t* Ks = (LAS bf16_t*)lds;
    LAS bf16_t* Vt = (LAS bf16_t*)(lds + ATT_VT_OFF);
    { u32x4 kva[4], vva[4];
#pragma unroll
      for (int it = 0; it < 4; ++it) { const int c = tid + it * 512, key = c >> 3, part = c & 7; const bool ok = blk > 0 || key >= 128;
          const size_t g = (size_t)(ok ? tok0 - 128 + key : tok0) * 128 + kvh * 64 + part * 8; kva[it] = *(const u32x4*)(Kb + g); vva[it] = *(const u32x4*)(Vb + g); }
#pragma unroll
      for (int it = 0; it < 4; ++it) { const int c = tid + it * 512, key = c >> 3, part = c & 7; const bool ok = blk > 0 || key >= 128;
          const u32x4 z = {0u, 0u, 0u, 0u}; const u32x4 kv = ok ? kva[it] : z, vv = ok ? vva[it] : z;
          *(LAS u32x4*)(Ks + key * 72 + part * 8) = kv;
          LAS bf16_t* vp = Vt + (part * 8) * 280 + key;
          vp[0 * 280] = (bf16_t)(vv.x & 0xffffu); vp[1 * 280] = (bf16_t)(vv.x >> 16); vp[2 * 280] = (bf16_t)(vv.y & 0xffffu); vp[3 * 280] = (bf16_t)(vv.y >> 16);
          vp[4 * 280] = (bf16_t)(vv.z & 0xffffu); vp[5 * 280] = (bf16_t)(vv.z >> 16); vp[6 * 280] = (bf16_t)(vv.w & 0xffffu); vp[7 * 280] = (bf16_t)(vv.w >> 16); } }
    for (int i = tid; i < 576; i += 512) ((LAS unsigned*)(Ks + 256 * 72))[i] = 0u;
    for (int i = tid; i < 1536; i += 512) { const int r = i / 24, c = i % 24; Vt[r * 280 + 256 + c] = 0; }
    const int w = tid >> 6, lane = tid & 63, l15 = lane & 15, q4 = lane >> 4;
    const int h = kvh * 4 + (w >> 1), qh = w & 1;
    bf16x8 qfa[4][2];
#pragma unroll
    for (int qt = 0; qt < 4; ++qt) { const bf16_t* qp = Q + (size_t)(tok0 + qh * 64 + qt * 16 + l15) * 512 + h * 64 + 8 * q4; qfa[qt][0] = *(const bf16x8*)qp; qfa[qt][1] = *(const bf16x8*)(qp + 32); }
    __syncthreads();
    const float sink = sinks[h];
#pragma unroll
    for (int qt = 0; qt < 4; ++qt) {
        const int qi0 = qh * 64 + qt * 16;
        const bf16x8 qf0 = qfa[qt][0], qf1 = qfa[qt][1];
        f32x4 s[10];
#pragma unroll
        for (int kt = 0; kt < 9; ++kt) {
            const LAS bf16_t* kp = Ks + (qi0 + 16 * kt + l15) * 72 + 8 * q4;
            const bf16x8 a0 = *(const LAS bf16x8*)kp, a1 = *(const LAS bf16x8*)(kp + 32);
            f32x4 z = {0.f, 0.f, 0.f, 0.f};
            z = MFMA16(a0, qf0, z); s[kt] = MFMA16(a1, qf1, z);
        }
        s[9] = (f32x4){0.f, 0.f, 0.f, 0.f};
        float mx = sink;
#pragma unroll
        for (int kt = 0; kt < 9; ++kt)
#pragma unroll
            for (int i = 0; i < 4; ++i) {
                const int rel = 16 * kt + 4 * q4 + i - l15;
                const bool valid = rel >= 1 && rel <= 128 && (blk > 0 || (qi0 + 16 * kt + 4 * q4 + i) >= 128);
                const float sv = valid ? s[kt][i] : -1e30f; s[kt][i] = sv; mx = fmaxf(mx, sv);
            }
        mx = fmaxf(mx, __shfl_xor(mx, 16)); mx = fmaxf(mx, __shfl_xor(mx, 32));
        float sum = 0.f;
#pragma unroll
        for (int kt = 0; kt < 9; ++kt)
#pragma unroll
            for (int i = 0; i < 4; ++i) { const float p = __expf(s[kt][i] - mx); s[kt][i] = p; sum += p; }
        sum += __shfl_xor(sum, 16); sum += __shfl_xor(sum, 32);
        const float inv = 1.0f / (sum + __expf(sink - mx));
        bf16x8 pb[5];
#pragma unroll
        for (int kp = 0; kp < 5; ++kp) pb[kp] = __builtin_bit_cast(bf16x8, pack8(s[2 * kp], s[2 * kp + 1]));
        f32x4 o[4];
#pragma unroll
        for (int dt = 0; dt < 4; ++dt) {
            o[dt] = (f32x4){0.f, 0.f, 0.f, 0.f};
#pragma unroll
            for (int kp = 0; kp < 5; ++kp) {
                const LAS bf16_t* vp = Vt + (dt * 16 + l15) * 280 + qi0 + 32 * kp + 4 * q4;
                const u32x2 lo = *(const LAS u32x2*)vp, hi = *(const LAS u32x2*)(vp + 16);
                u32x4 av; av.x = lo.x; av.y = lo.y; av.z = hi.x; av.w = hi.y;
                o[dt] = MFMA16(__builtin_bit_cast(bf16x8, av), pb[kp], o[dt]);
            }
        }
        bf16_t* op = ATT + (size_t)(tok0 + qi0 + l15) * 512 + h * 64 + 4 * q4;
#pragma unroll
        for (int dt = 0; dt < 4; ++dt) { u32x2 wv; wv.x = cvt_pk_bf16(o[dt].x * inv, o[dt].y * inv); wv.y = cvt_pk_bf16(o[dt].z * inv, o[dt].w * inv); *(u32x2*)(op + dt * 16) = wv; }
    }
    __syncthreads();
}

__device__ __forceinline__ void attn_sample_item(LAS unsigned char* ldsw, const bf16_t* Q, const bf16_t* Kb, const bf16_t* Vb, const float* sk, const float* sv, bf16_t* ATT, const float* sinks, int item, int lane) {
    const int b = item >> 3, h = item & 7, kvh = h >> 2, rowb = TP + b * 4;
    LAS float* qs = (LAS float*)ldsw;
    LAS float* ps = (LAS float*)(ldsw + 1024);
#pragma unroll
    for (int t = 0; t < 4; ++t) qs[t * 64 + lane] = bf2f(Q[(size_t)(rowb + t) * 512 + h * 64 + lane]);
    asm volatile("s_waitcnt lgkmcnt(0)" ::: "memory");
    float sc[3][4];
#pragma unroll
    for (int t = 0; t < 4; ++t) sc[2][t] = 0.f;
#pragma unroll
    for (int sl = 0; sl < 2; ++sl) {
        const int j = lane + 64 * sl; const float* kp = sk + ((size_t)(b * 128 + j) * 2 + kvh) * 64;
        float s0 = 0.f, s1 = 0.f, s2 = 0.f, s3 = 0.f;
#pragma unroll 1
        for (int c = 0; c < 16; c += 8) {
            f32x4 kk[8];
#pragma unroll
            for (int cc = 0; cc < 8; ++cc) kk[cc] = *(const f32x4*)(kp + 4 * (c + cc));
#pragma unroll
            for (int cc = 0; cc < 8; ++cc) { const f32x4 k4 = kk[cc]; const LAS float* qq = qs + 4 * (c + cc);
                const f32x4 q0 = *(const LAS f32x4*)(qq), q1 = *(const LAS f32x4*)(qq + 64), q2 = *(const LAS f32x4*)(qq + 128), q3 = *(const LAS f32x4*)(qq + 192);
                s0 += (k4.x * q0.x + k4.y * q0.y) + (k4.z * q0.z + k4.w * q0.w); s1 += (k4.x * q1.x + k4.y * q1.y) + (k4.z * q1.z + k4.w * q1.w);
                s2 += (k4.x * q2.x + k4.y * q2.y) + (k4.z * q2.z + k4.w * q2.w); s3 += (k4.x * q3.x + k4.y * q3.y) + (k4.z * q3.z + k4.w * q3.w); }
        }
        sc[sl][0] = s0; sc[sl][1] = s1; sc[sl][2] = s2; sc[sl][3] = s3;
        asm volatile("" ::: "memory");
    }
    if (lane < 4) { const bf16_t* kp = Kb + (size_t)(rowb + lane) * 128 + kvh * 64;
        u32x2 kn[16];
#pragma unroll
        for (int c = 0; c < 16; ++c) kn[c] = *(const u32x2*)(kp + 4 * c);
#pragma unroll
        for (int c = 0; c < 16; ++c) { const u32x2 kk = kn[c];
            const float k0 = __uint_as_float(kk.x << 16), k1 = __uint_as_float(kk.x & 0xffff0000u), k2 = __uint_as_float(kk.y << 16), k3 = __uint_as_float(kk.y & 0xffff0000u);
#pragma unroll
            for (int t = 0; t < 4; ++t) { const f32x4 q4 = *(const LAS f32x4*)(qs + t * 64 + 4 * c); sc[2][t] += (k0 * q4.x + k1 * q4.y) + (k2 * q4.z + k3 * q4.w); } }
    }
    const float sink = sinks[h];
    float den[4];
#pragma unroll
    for (int t = 0; t < 4; ++t) {
        float mx = sink; bool vd[3];
#pragma unroll
        for (int sl = 0; sl < 3; ++sl) { const int j = lane + 64 * sl; vd[sl] = (j >= t + 1) && (j <= t + 128) && (j < 132); if (vd[sl]) mx = fmaxf(mx, sc[sl][t]); }
        mx = wave_max(mx);
        float sum = 0.f;
#pragma unroll
        for (int sl = 0; sl < 3; ++sl) { const int j = lane + 64 * sl; const float p = vd[sl] ? __expf(sc[sl][t] - mx) : 0.f; sum += p; if (j < 132) ps[t * 132 + j] = p; }
        sum = wave_sum(sum);
        den[t] = sum + __expf(sink - mx);
    }
    asm volatile("s_waitcnt lgkmcnt(0)" ::: "memory");
    float o[4] = {0.f, 0.f, 0.f, 0.f};
    const float* vp = sv + ((size_t)(b * 128) * 2 + kvh) * 64 + lane;
#pragma unroll 1
    for (int j0 = 0; j0 < 128; j0 += 32) {
        float vv[32];
#pragma unroll
        for (int jj = 0; jj < 32; ++jj) vv[jj] = vp[(size_t)(j0 + jj) * 128];
        asm volatile("" ::: "memory");
#pragma unroll
        for (int jj = 0; jj < 32; ++jj)
#pragma unroll
            for (int t = 0; t < 4; ++t) o[t] += ps[t * 132 + j0 + jj] * vv[jj];
    }
#pragma unroll
    for (int j = 0; j < 4; ++j) { const float v = bf2f(Vb[(size_t)(rowb + j) * 128 + kvh * 64 + lane]);
#pragma unroll
        for (int t = 0; t < 4; ++t) o[t] += ps[t * 132 + 128 + j] * v; }
#pragma unroll
    for (int t = 0; t < 4; ++t) ATT[(size_t)(rowb + t) * 512 + h * 64 + lane] = (bf16_t)(cvt_pk_bf16(o[t] / den[t], 0.f) & 0xffffu);
    asm volatile("s_waitcnt lgkmcnt(0)" ::: "memory");
}

template <int T, bool SAMPLE>
__device__ __forceinline__ void conv_phase(LAS unsigned char* lds, const bf16_t* U, const float* state_conv, const float* cw, const float* cb, const float* lng, const float* lnb, bf16_t* CV, int it0, int nit, int stride, int tid) {
    if (it0 >= nit) return;
    const int cp = tid & 255, c0 = 2 * cp, th = __builtin_amdgcn_readfirstlane(tid >> 8), wv = __builtin_amdgcn_readfirstlane(tid >> 6), lane = tid & 63;
    float w0[31], w1[31];
#pragma unroll
    for (int j = 0; j < 31; ++j) { const f32x2 ww = *(const f32x2*)(cw + j * 512 + c0); w0[j] = ww.x; w1[j] = ww.y; }
    const f32x2 bias = *(const f32x2*)(cb + c0), gg = *(const f32x2*)(lng + c0), bb2 = *(const f32x2*)(lnb + c0);
    const unsigned* Uc = (const unsigned*)U + cp;
    const f32x2* Sc = (const f32x2*)state_conv + cp;
    unsigned* CVc = (unsigned*)CV + cp;
    LAS float* red = (LAS float*)(lds + CONV_RED_OFF);
    unsigned praw[T + 30];
    if (!SAMPLE) { const int rowf = it0 * 16 + th * 8, tl0 = rowf & 4095;
#pragma unroll
        for (int si = 0; si < T + 30; ++si) { const bool ok = tl0 + si - 30 >= 0; praw[si] = Uc[(size_t)(ok ? rowf + si - 30 : rowf) * 256]; } }
    for (int item = it0; item < nit; item += stride) {
        int rowf, tl0 = 0, bs = 0;
        if (SAMPLE) { bs = item * 2 + th; rowf = TP + bs * 4; }
        else { rowf = item * 16 + th * 8; tl0 = rowf & 4095; }
        f32x2 ac[T];
#pragma unroll
        for (int t = 0; t < T; ++t) ac[t] = bias;
        float u0a[T + 30], u1a[T + 30];
#pragma unroll
        for (int si = 0; si < T + 30; ++si) {
            if (SAMPLE) {
                if (si < 30) { const f32x2 uu = Sc[(size_t)(bs * 30 + si) * 256]; u0a[si] = uu.x; u1a[si] = uu.y; }
                else { const unsigned uu = Uc[(size_t)(rowf + si - 30) * 256]; u0a[si] = __uint_as_float(uu << 16); u1a[si] = __uint_as_float(uu & 0xffff0000u); }
            } else {
                const bool ok = tl0 + si - 30 >= 0; const unsigned uu = praw[si]; u0a[si] = ok ? __uint_as_float(uu << 16) : 0.f; u1a[si] = ok ? __uint_as_float(uu & 0xffff0000u) : 0.f;
            }
        }
        asm volatile("" ::: "memory");
        if (!SAMPLE && item + stride < nit) { const int rown = (item + stride) * 16 + th * 8, tln = rown & 4095;
#pragma unroll
            for (int si = 0; si < T + 30; ++si) { const bool ok = tln + si - 30 >= 0; praw[si] = Uc[(size_t)(ok ? rown + si - 30 : rown) * 256]; } }
#pragma unroll
        for (int si = 0; si < T + 30; ++si) {
#pragma unroll
            for (int t = 0; t < T; ++t) { const int j = si - t; if (j >= 0 && j <= 30) ac[t] += (f32x2){w0[j], w1[j]} * (f32x2){u0a[si], u1a[si]}; }
        }
        { float rs[2 * T];
#pragma unroll
          for (int t = 0; t < T; ++t) { rs[2 * t] = ac[t].x + ac[t].y; rs[2 * t + 1] = ac[t].x * ac[t].x + ac[t].y * ac[t].y; }
#pragma unroll
          for (int o = 1; o < 64; o <<= 1) { float tmp[2 * T];
#pragma unroll
              for (int q = 0; q < 2 * T; ++q) tmp[q] = __shfl_xor(rs[q], o);
#pragma unroll
              for (int q = 0; q < 2 * T; ++q) rs[q] += tmp[q]; }
          if (lane == 0) {
#pragma unroll
              for (int q = 0; q < 2 * T; ++q) red[wv * 2 * T + q] = rs[q]; } }
        __syncthreads();
#pragma unroll
        for (int t = 0; t < T; ++t) {
            float s1 = 0.f, s2 = 0.f;
#pragma unroll
            for (int k = 0; k < 4; ++k) { s1 += red[(th * 4 + k) * 2 * T + 2 * t]; s2 += red[(th * 4 + k) * 2 * T + 2 * t + 1]; }
            const float mean = s1 * (1.0f / 512.0f), var = fmaxf(s2 * (1.0f / 512.0f) - mean * mean, 0.f), rstd = rsqrtf(var + 1e-5f);
            const float n0 = (ac[t].x - mean) * rstd * gg.x + bb2.x, n1 = (ac[t].y - mean) * rstd * gg.y + bb2.y;
            CVc[(size_t)(rowf + t) * 256] = cvt_pk_bf16(n0 * sigm(n0), n1 * sigm(n1));
        }
        __syncthreads();
    }
}
#define XB_TMO      128
#define XB_XCNT(j)  (256  + 64 * (j))
#define XB_XSUB(j)  (1280 + 64 * (j))
#define XB_XGEN(j)  (2304 + 64 * (j))
#define XB_TOP      3328
#define XB_TOPGEN   3392
#define XCD_BAR_WORDS 3456
#define XB_SPIN_CAP (1u << 18)

__device__ __forceinline__ unsigned xb_ld(unsigned* p)              { return __hip_atomic_load(p, __ATOMIC_RELAXED, __HIP_MEMORY_SCOPE_AGENT); }
__device__ __forceinline__ unsigned xb_add(unsigned* p, unsigned v) { return __hip_atomic_fetch_add(p, v, __ATOMIC_RELAXED, __HIP_MEMORY_SCOPE_AGENT); }
__device__ __forceinline__ unsigned xb_xcc_id() { return (unsigned)__builtin_amdgcn_s_getreg((3 << 11) | 20) & 0xFu; }
#define XB_SPIN(cond, bar) do { unsigned _sp = 0; while (cond) { __builtin_amdgcn_s_sleep(1); \
    if ((++_sp & 255u) == 0u) { if (xb_ld(&(bar)[XB_TMO])) break; if (_sp > XB_SPIN_CAP) { atomicAdd(&(bar)[XB_TMO], 1u); break; } } } } while (0)

struct XcdBarrier {
    unsigned* bar; unsigned x;
    volatile LAS unsigned* st;
};

__device__ __forceinline__ XcdBarrier xcd_barrier_post(unsigned* bar, volatile LAS unsigned* st) {
    XcdBarrier b; b.bar = bar; b.x = xb_xcc_id(); b.st = st;
    if (threadIdx.x == 0) (void)xb_add(&bar[XB_XCNT(b.x)], 1u);
    return b;
}
__device__ __forceinline__ void xcd_barrier_complete(unsigned* bar, unsigned x, unsigned& nloc, unsigned& nx) {
    const unsigned G = gridDim.x * gridDim.y * gridDim.z;
    unsigned sum, cnt, mine, sp = 0u;
    for (;;) {
        sum = 0u; cnt = 0u; mine = 0u;
#pragma unroll
        for (unsigned j = 0; j < 16; ++j) { const unsigned c = xb_ld(&bar[XB_XCNT(j)]); sum += c; cnt += (c > 0u) ? 1u : 0u; mine = (j == x) ? c : mine; }
        if (sum == G) break;
        __builtin_amdgcn_s_sleep(1);
        if ((++sp & 255u) == 0u) { if (xb_ld(&bar[XB_TMO])) break; if (sp > XB_SPIN_CAP) { atomicAdd(&bar[XB_TMO], 1u); break; } }
    }
    nloc = mine > 0u ? mine : 1u; nx = cnt > 0u ? cnt : 1u;
}

__device__ __forceinline__ void xcd_barrier(const XcdBarrier& b) {
    asm volatile("s_waitcnt vmcnt(0)" ::: "memory");
    __syncthreads();
    if (threadIdx.x == 0) {
        unsigned* bar = b.bar;
        __builtin_amdgcn_s_waitcnt(0);
        unsigned nloc = b.st[0], nx = b.st[1];
        if (nloc == 0u) { xcd_barrier_complete(bar, b.x, nloc, nx); b.st[0] = nloc; b.st[1] = nx; }
        const unsigned old = xb_add(&bar[XB_XSUB(b.x)], 1u);
        const unsigned gen = old / nloc;
        if (old + 1u == (gen + 1u) * nloc) {
            __builtin_amdgcn_fence(__ATOMIC_RELEASE, "agent");
            asm volatile("s_waitcnt vmcnt(0)" ::: "memory");
            const unsigned og = xb_add(&bar[XB_TOP], 1u);
            const unsigned tg = og / nx;
            if (og + 1u == (tg + 1u) * nx) xb_add(&bar[XB_TOPGEN], 1u);
            else XB_SPIN(xb_ld(&bar[XB_TOPGEN]) == tg, bar);
            __builtin_amdgcn_fence(__ATOMIC_ACQUIRE, "agent");
            xb_add(&bar[XB_XGEN(b.x)], 1u);
            asm volatile("s_waitcnt vmcnt(0)" ::: "memory");
        } else {
            XB_SPIN(xb_ld(&bar[XB_XGEN(b.x)]) == gen, bar);
            __builtin_amdgcn_fence(__ATOMIC_ACQUIRE, "agent");
            asm volatile("s_waitcnt vmcnt(0)" ::: "memory");
        }
    }
    __syncthreads();
}
constexpr int MISC_OFF = 131072 + 320;
__device__ __forceinline__ void stagger(int bid, unsigned step_ticks) {
    const unsigned long long t0 = __builtin_amdgcn_s_memrealtime();
    const unsigned long long d = (unsigned long long)(((unsigned)bid >> 3) & 7u) * step_ticks;
    while (__builtin_amdgcn_s_memrealtime() - t0 < d) __builtin_amdgcn_s_sleep(16);
}
#ifndef STG2
#define STG2 400
#endif
template <int LIM, bool FIRST>
__device__ __forceinline__ void program(const Args& a, LAS unsigned char* lds, cg::grid_group& grid, XcdBarrier& bar, unsigned* barw, volatile LAS unsigned* MISC) {
    const int tid = threadIdx.x, lane = tid & 63, wave = __builtin_amdgcn_readfirstlane(tid >> 6);
    const int G = gridDim.x, bid = blockIdx.x, gw = bid * 8 + wave, ngw = G * 8;
    unsigned char* ws = a.ws; float* out = a.out;
    float* mods = (float*)(ws + WS_MODS);
    bf16_t *Wi = (bf16_t*)(ws + WS_WIN), *Wao = (bf16_t*)(ws + WS_WAO), *Wco = (bf16_t*)(ws + WS_WCO), *Wo = (bf16_t*)(ws + WS_WOUT), *Wf1 = (bf16_t*)(ws + WS_WF1), *Wf2 = (bf16_t*)(ws + WS_WF2);
    bf16_t *H = (bf16_t*)(ws + WS_H), *Q = (bf16_t*)(ws + WS_Q), *Kb = (bf16_t*)(ws + WS_K), *Vb = (bf16_t*)(ws + WS_V), *U = (bf16_t*)(ws + WS_U), *GA = (bf16_t*)(ws + WS_GA), *GC = (bf16_t*)(ws + WS_GC);
    bf16_t *PB = (bf16_t*)(ws + WS_ATT);
    bf16_t *ATT = (bf16_t*)(ws + WS_Q), *CV = (bf16_t*)(ws + WS_CV), *MM = (bf16_t*)(ws + WS_GA), *ACT = (bf16_t*)(ws + WS_ACT);
    if (LIM > 0) {
        for (int it = bid; it < 192; it += G) mods_item(lds, a.in[I_CP], a.in[I_CS], a.in[I_WADA], a.in[I_BADA], mods, it, tid);
    }
    xcd_barrier(bar);
    if (LIM > 1) {
        __syncthreads();
        LAS float* scr = (LAS float*)(lds + wave * 16384);
        constexpr int T_IN = 16 * 120, T_AO = 8 * 32, T_CO = 8 * 32, T_OUT = 16 * 32, T_F1 = 16 * 176, T_F2 = 44 * 32;
        for (int it = gw; it < T_IN + T_AO + T_CO + T_OUT + T_F1 + T_F2; it += ngw) {
            int r = it;
            if (r < T_IN) { transpose_item(a.in[I_WIN], D, NIN, Wi, 1, scr, r, lane); continue; } r -= T_IN;
            if (r < T_AO) { transpose_item(a.in[I_WAO], 512, D, Wao, 0, scr, r, lane); continue; } r -= T_AO;
            if (r < T_CO) { transpose_item(a.in[I_WCO], 512, D, Wco, 0, scr, r, lane); continue; } r -= T_CO;
            if (r < T_OUT) { transpose_item(a.in[I_WOUT], D, D, Wo, 0, scr, r, lane); continue; } r -= T_OUT;
            if (r < T_F1) { transpose_item(a.in[I_WF1], D, 2 * FF, Wf1, 2, scr, r, lane); continue; } r -= T_F1;
            transpose_item(a.in[I_WF2], FF, D, Wf2, 0, scr, r, lane);
        }
        const int gt = bid * 512 + tid, ngt = G * 512;
        for (int i0 = gt; i0 < 128 * 3968; i0 += 4 * ngt) {
            f32x4 kk[4], vv[4];
#pragma unroll
            for (int u = 0; u < 4; ++u) { const int i = min(i0 + u * ngt, 128 * 3968 - 1), b = i / 3968, o = i % 3968;
                kk[u] = ((const f32x4*)(a.in[I_SK] + (size_t)b * 16384 + 512))[o]; vv[u] = ((const f32x4*)(a.in[I_SV] + (size_t)b * 16384 + 512))[o]; }
#pragma unroll
            for (int u = 0; u < 4; ++u) { const int i = i0 + u * ngt; if (i < 128 * 3968) { const int b = i / 3968, o = i % 3968;
                ((f32x4*)(out + O_KS + (size_t)b * 16384))[o] = kk[u]; ((f32x4*)(out + O_VS + (size_t)b * 16384))[o] = vv[u]; } }
        }
        for (int i0 = gt; i0 < 128 * 3328; i0 += 4 * ngt) {
            f32x4 cc[4];
#pragma unroll
            for (int u = 0; u < 4; ++u) { const int i = min(i0 + u * ngt, 128 * 3328 - 1), b = i / 3328, o = i % 3328; cc[u] = ((const f32x4*)(a.in[I_SC] + (size_t)b * 15360 + 2048))[o]; }
#pragma unroll
            for (int u = 0; u < 4; ++u) { const int i = i0 + u * ngt; if (i < 128 * 3328) { const int b = i / 3328, o = i % 3328; ((f32x4*)(out + O_CS + (size_t)b * 15360))[o] = cc[u]; } }
        }
        }
    if (LIM > 1) { rows_norm_mod(a.in[I_XP], a.in[I_XS], a.in[I_N1], mods, 0, H, out, gw, ngw, lane);
        xcd_barrier(bar); }
    if (LIM > 2) {
        __syncthreads();
        pg8::Gemm g{H, Wi, MT, NIN, D}; pg8::StaticOrder S; S.init(MT, NIN, D, G, bid);
        EpiIn E{Q, Kb, Vb, U, GA, GC, out};
        pg8::gemm_phase<EpiIn, pg8::StaticOrder>(lds, g, S, E, nullptr);
        xcd_barrier(bar);
    }
    if (LIM > 3) {
        __syncthreads();
        for (int it = bid; it < 512; it += G) attn_prompt_item(lds, Q, Kb, Vb, ATT, a.in[I_SINKS], it, tid);
        for (int it = gw; it < 1024; it += ngw) attn_sample_item(lds + SATT_OFF + wave * 4096, Q, Kb, Vb, a.in[I_SK], a.in[I_SV], ATT, a.in[I_SINKS], it, lane);
        __syncthreads();
        if (G == 256) { const int c0_ = bid < 128 ? bid * 7 : 896 + (bid - 128) * 9, n_ = bid < 128 ? 7 : 9;
            conv_phase<8, false>(lds, U, a.in[I_SC], a.in[I_CONVW], a.in[I_CONVB], a.in[I_LNG], a.in[I_LNB], CV, c0_, c0_ + n_, 1, tid); }
        else conv_phase<8, false>(lds, U, a.in[I_SC], a.in[I_CONVW], a.in[I_CONVB], a.in[I_LNG], a.in[I_LNB], CV, bid, 2048, G, tid);
        conv_phase<4, true>(lds, U, a.in[I_SC], a.in[I_CONVW], a.in[I_CONVB], a.in[I_LNG], a.in[I_LNB], CV, G - 1 - bid, 64, G, tid);
        xcd_barrier(bar);
    }
    if (LIM > 4) {
        __syncthreads();
        pg8::Gemm g{ATT, Wao, MT, D, 512, CV, Wco}; MergeOrder S; S.init(G, bid); EpiMerge E{GA, GC, MM};
        pg8::gemm_phase<EpiMerge, MergeOrder>(lds, g, S, E, nullptr);
        if (bid < 16) { __syncthreads(); SampleHalfOrder S2; S2.init(G, bid); EpiHalf E2{GA, GC, MM, PB - (size_t)TP * D}; pg8::gemm_phase<EpiHalf, SampleHalfOrder>(lds, g, S2, E2, nullptr); }
        xcd_barrier(bar);
    }
    if (LIM > 5) {
        __syncthreads();
        pg8::Gemm g{MM, Wo, MT, D, D, PB - (size_t)TP * D, Wo}; TailSplitOrder<1> S; S.init(D, 4, G, bid);
        EpiRes E{a.in[I_XP], mods + 2 * 1024, out};
        pg8::gemm_phase<EpiRes, TailSplitOrder<1>>(lds, g, S, E, nullptr);
        xcd_barrier(bar);
    }
    if (LIM > 6) { rows_norm_mod(out, out + (size_t)TP * D, a.in[I_N2], mods, 3, H, nullptr, gw, ngw, lane);
        xcd_barrier(bar); }
    if (LIM > 7) {
        __syncthreads();
        pg8::Gemm g{H, Wf1, MT, 2 * FF, D}; pg8::StaticOrder S; S.init(MT, 2 * FF, D, G, bid);
        EpiSwi E{ACT};
        pg8::gemm_phase<EpiSwi, pg8::StaticOrder>(lds, g, S, E, nullptr);
        if (FIRST) grid.sync();
        else xcd_barrier(bar);
    }
    if (LIM > 8) {
        __syncthreads();
        pg8::Gemm g{ACT, Wf2, MT, D, FF}; TailSplitOrder<0> S; S.init(FF, 11, G, bid);
        EpiRes E{out, mods + 5 * 1024, out};
        pg8::gemm_phase<EpiRes, TailSplitOrder<0>>(lds, g, S, E, nullptr);
        xcd_barrier(bar);
    }
    if (LIM > 9) rows_final(out, out, a.in[I_FNG], gw, ngw, lane);
}

#ifndef PREFIX
#define PREFIX 0
#endif
__global__ void __launch_bounds__(512, 2) mega(Args a) {
    extern __shared__ __attribute__((aligned(16))) unsigned char lds_raw[];
    cg::grid_group grid = cg::this_grid();
    LAS unsigned char* lds = (LAS unsigned char*)lds_raw;
    unsigned* barw = (unsigned*)a.ws;
    volatile LAS unsigned* MISC = (volatile LAS unsigned*)(lds + MISC_OFF);
    if (threadIdx.x < 2) MISC[threadIdx.x] = 0u;
    __syncthreads();
    XcdBarrier bar = xcd_barrier_post(barw, MISC);
#if PREFIX > 0
    program<PREFIX, true>(a, lds, grid, bar, barw, MISC);
    asm volatile("" ::: "memory");
    program<10, false>(a, lds, grid, bar, barw, MISC);
#else
    program<10, true>(a, lds, grid, bar, barw, MISC);
#endif
}

extern "C" void kernel_launch(void* const* d_in, const int* in_sizes, int n_in, void* d_out, int out_size, void* d_ws, size_t ws_size, hipStream_t stream) {
    static int grid = 0;
    if (grid == 0) {
        int dev = 0, cus = 0, per_cu = 0;
        if (n_in != 23 || ws_size < WS_END) { fprintf(stderr, "kernel_launch: unexpected n_in %d / ws %zu\n", n_in, ws_size); grid = -1; return; }
        (void)hipGetDevice(&dev);
        (void)hipDeviceGetAttribute(&cus, hipDeviceAttributeMultiprocessorCount, dev);
        if (hipFuncSetAttribute((const void*)mega, hipFuncAttributeMaxDynamicSharedMemorySize, LDS_BYTES) != hipSuccess) { fprintf(stderr, "kernel_launch: hipFuncSetAttribute failed\n"); grid = -1; return; }
        if (hipOccupancyMaxActiveBlocksPerMultiprocessor(&per_cu, (const void*)mega, 512, LDS_BYTES) != hipSuccess || per_cu < 1) { fprintf(stderr, "kernel_launch: occupancy query says %d\n", per_cu); (void)hipGetLastError(); grid = -1; return; }
        grid = cus;
    }
    if (grid < 0) return;
    Args a{};
    for (int i = 0; i < 23; ++i) a.in[i] = (const float*)d_in[i];
    a.out = (float*)d_out; a.ws = (unsigned char*)d_ws; a.ph_lo = 0; a.ph_hi = NPH;
    void* args[] = {&a};
    (void)hipMemsetAsync(d_ws, 0, 16384, stream);
    hipError_t e = hipLaunchCooperativeKernel((const void*)mega, dim3(grid), dim3(512), args, LDS_BYTES, stream);
    if (e != hipSuccess) fprintf(stderr, "cooperative launch failed: %s (grid %d)\n", hipGetErrorString(e), grid);
}
```

```cpp
#include <hip/hip_runtime.h>
#include <hip/hip_cooperative_groups.h>
#include <cstdio>
namespace cg = cooperative_groups;
namespace pg8 {
#define PG8_LAS __attribute__((address_space(3)))
typedef unsigned short bf16_t;
typedef short bf16x8 __attribute__((ext_vector_type(8)));
typedef float f32x4 __attribute__((ext_vector_type(4)));
typedef unsigned u32x4 __attribute__((ext_vector_type(4)));
constexpr int BM = 256, BK = 64, HALF = 128, HTB = HALF * BK * 2  , STAGE_BYTES = 8 * HTB, NXCD = 8, WGM = 8;

__host__ __device__ __forceinline__ int lds_byte(int r, int c) { const int st = (r >> 4) * 2 + (c >> 5), rr = r & 15, cc = c & 31, ob = rr * 64 + cc * 2; return st * 1024 + (ob ^ (((ob >> 9) & 1) << 5)); }
__host__ __device__ __forceinline__ void stage_rc(int b, int& R, int& C) { const int st = b / 1024, sb = b % 1024, swz = sb ^ (((sb >> 9) & 1) << 5); R = (st >> 1) * 16 + swz / 64; C = (st & 1) * 32 + (swz % 64) / 2; }
__host__ __device__ __forceinline__ int perm32(int rho) { const int n = rho >> 4, i = rho & 15; return 8 * (i >> 2) + 4 * n + (i & 3); }

struct Unit { int pm, pn, k0, nt, sel; };
struct Gemm { const bf16_t* A; const bf16_t* Bt; int M, N, K; const bf16_t* A2; const bf16_t* Bt2; };

struct StaticOrder {
    int nM, nN, nwg, G, c, ntk;
    __host__ __device__ void init(int M, int N, int K, int G_, int c_) { nM = M / BM; nN = N / BM; nwg = nM * nN; G = G_; c = c_; ntk = K / BK; }
    __host__ __device__ __forceinline__ bool next(int i, Unit& u) const {
        const long L = (long)i * G + c; if (L >= nwg) return false;
        int wgid = (int)L; { const int q = nwg / NXCD, r = nwg % NXCD, xcd = wgid % NXCD, off = wgid / NXCD; wgid = (xcd < r ? xcd * (q + 1) : r * (q + 1) + (xcd - r) * q) + off; }
        const int nig = WGM * nN, gid = wgid / nig, fm = gid * WGM, gsz = (nM - fm) < WGM ? (nM - fm) : WGM;
        u.pm = fm + ((wgid % nig) % gsz); u.pn = (wgid % nig) / gsz; u.k0 = 0; u.nt = ntk; u.sel = 0; return true;
    }
    __device__ __forceinline__ void a_ready(const Unit&) const {}
    __device__ __forceinline__ void done(const Unit&) const {}
};
typedef float f32x2_cv __attribute__((ext_vector_type(2)));
typedef __bf16 bf16x2_cv __attribute__((ext_vector_type(2)));
__device__ __forceinline__ unsigned cvt_pk_bf16(float lo, float hi) { const f32x2_cv v = {lo, hi}; return __builtin_bit_cast(unsigned, __builtin_convertvector(v, bf16x2_cv)); }
template <class Epi, class Sched, bool STAMP = false>
__device__ __forceinline__ void gemm_phase(PG8_LAS unsigned char* lds, const Gemm g, const Sched& S, const Epi& E, unsigned long long* stamps) {
    int tid_ = threadIdx.x; asm volatile("" : "+v"(tid_));
    const int tid = tid_, wid = __builtin_amdgcn_readfirstlane(tid >> 6), lane = tid & 63, wr = wid >> 2, wc = wid & 3, fr = lane & 15, fq = lane >> 4;
    const int K = g.K;
    int ts_lo = 0, ts_hi = 0, nts = 0; const unsigned long long rt_entry = STAMP ? (unsigned long long)wall_clock64() : 0ull;
#define PG8_STAMP() do { if (STAMP && wid == 0 && nts < 64) { const unsigned long long _c = (unsigned long long)clock64(); \
        ts_lo = (lane == nts) ? (int)(unsigned)_c : ts_lo; ts_hi = (lane == nts) ? (int)(unsigned)(_c >> 32) : ts_hi; ++nts; } } while (0)
    PG8_STAMP();
    unsigned voffA[2], voffB[2];
#pragma unroll
    for (int i = 0; i < 2; ++i) { int R, C; stage_rc(tid * 16 + i * 8192, R, C); const int Rb = Epi::PERM ? ((R & ~31) + perm32(R & 31)) : R;
        voffA[i] = (unsigned)(R * K + C) * 2u; voffB[i] = (unsigned)(Rb * K + C) * 2u; }
    const size_t kstep = (size_t)(BK * 2);
    const size_t hstep = (size_t)HALF * K * 2;
    const size_t tstep = 2 * hstep;
    const unsigned ldsw = (unsigned)wid * 1024u;
    const int aoff = lds_byte(wr * 64 + fr, fq * 8), boff = lds_byte(wc * 32 + fr, fq * 8);
#define PG8_SA(b, h) (((b) * 2 + (h)) * HTB)
#define PG8_SB(b, h) ((4 + (b) * 2 + (h)) * HTB)
#define PG8_STAGE(bufoff, gbase, voff) do { _Pragma("unroll") for (int _i = 0; _i < 2; ++_i) \
        __builtin_amdgcn_global_load_lds((const unsigned*)((const char*)(gbase) + (voff)[_i]), (PG8_LAS unsigned*)(lds + (bufoff) + ldsw + _i * 8192), 16, 0, 0); } while (0)
#define PG8_LDA(dst, b, h) do { _Pragma("unroll") for (int m = 0; m < 4; ++m) _Pragma("unroll") for (int k = 0; k < 2; ++k) dst[m][k] = *(const PG8_LAS bf16x8*)(lds + PG8_SA(b, h) + aoff + m * 2048 + k * 1024); } while (0)
#define PG8_LDB(dst, b, h) do { _Pragma("unroll") for (int n = 0; n < 2; ++n) _Pragma("unroll") for (int k = 0; k < 2; ++k) dst[n][k] = *(const PG8_LAS bf16x8*)(lds + PG8_SB(b, h) + boff + n * 2048 + k * 1024); } while (0)
#define PG8_MMA(ai, bj, At, Bt) do { __builtin_amdgcn_s_setprio(1); _Pragma("unroll") for (int m = 0; m < 4; ++m) _Pragma("unroll") for (int n = 0; n < 2; ++n) _Pragma("unroll") for (int k = 0; k < 2; ++k) \
        acc[ai][bj][m][n] = __builtin_amdgcn_mfma_f32_16x16x32_bf16(Bt[n][k], At[m][k], acc[ai][bj][m][n], 0, 0, 0); __builtin_amdgcn_s_setprio(0); } while (0)
#define PG8_WAIT_V(n) asm volatile("s_waitcnt vmcnt(" #n ")" ::: "memory")
#define PG8_WAIT_L(n) asm volatile("s_waitcnt lgkmcnt(" #n ")" ::: "memory")
#define PG8_BAR __builtin_amdgcn_s_barrier()
#define PG8_SCHED __builtin_amdgcn_sched_barrier(0)
    Unit cur, nxt; int ui = 0;
    if (!S.next(0, cur)) return;
    f32x4 acc[2][2][4][2];
#pragma unroll
    for (int a = 0; a < 2; ++a)
#pragma unroll
        for (int b = 0; b < 2; ++b)
#pragma unroll
            for (int m = 0; m < 4; ++m)
#pragma unroll
                for (int n = 0; n < 2; ++n) acc[a][b][m][n] = (f32x4){0.f, 0.f, 0.f, 0.f};
    bf16x8 At[4][2], B0[2][2], B1[2][2];
    const char* cA = (const char*)((cur.sel & 1) ? g.A2 : g.A) + (size_t)cur.pm * tstep + (size_t)cur.k0 * 2; const char* cB = (const char*)((cur.sel & 1) ? g.Bt2 : g.Bt) + (size_t)cur.pn * tstep + (size_t)cur.k0 * 2;
    S.a_ready(cur);
    PG8_STAGE(PG8_SB(0, 0), cB, voffB); PG8_STAGE(PG8_SA(0, 0), cA, voffA); PG8_STAGE(PG8_SB(0, 1), cB + hstep, voffB); PG8_STAGE(PG8_SA(0, 1), cA + hstep, voffA);
    if (wr == 1) PG8_BAR;
    PG8_WAIT_V(4); PG8_BAR;
    PG8_STAGE(PG8_SB(1, 0), cB + kstep, voffB); PG8_STAGE(PG8_SA(1, 0), cA + kstep, voffA); PG8_STAGE(PG8_SB(1, 1), cB + hstep + kstep, voffB);
    PG8_WAIT_V(6); PG8_BAR;
    PG8_STAMP();
    for (;;) {
        const bool has_next = S.next(ui + 1, nxt);
        const char* nA = has_next ? (const char*)((nxt.sel & 1) ? g.A2 : g.A) + (size_t)nxt.pm * tstep + (size_t)nxt.k0 * 2 : cA; const char* nB = has_next ? (const char*)((nxt.sel & 1) ? g.Bt2 : g.Bt) + (size_t)nxt.pn * tstep + (size_t)nxt.k0 * 2 : cB;
        const int nt = cur.nt;
        for (int t = 0; t < nt; t += 2) {
            const bool last = (t == nt - 2);
            const char* a1 = cA + (size_t)(t + 1) * kstep;
            const char* a2 = last ? nA : cA + (size_t)(t + 2) * kstep; const char* b2 = last ? nB : cB + (size_t)(t + 2) * kstep;
            const char* a3 = a2 + kstep; const char* b3 = b2 + kstep;
            if (last && has_next) S.a_ready(nxt);
            PG8_LDB(B0, 0, 0); PG8_SCHED; PG8_LDA(At, 0, 0); PG8_STAGE(PG8_SA(1, 1), a1 + hstep, voffA);
            PG8_WAIT_L(8); PG8_BAR; PG8_WAIT_L(0); PG8_MMA(0, 0, At, B0); PG8_BAR; PG8_SCHED;
            PG8_LDB(B1, 0, 1); PG8_STAGE(PG8_SB(0, 0), b2, voffB);
            PG8_BAR; PG8_WAIT_L(0); PG8_MMA(0, 1, At, B1); PG8_BAR;
            PG8_LDA(At, 0, 1); PG8_STAGE(PG8_SA(0, 0), a2, voffA);
            PG8_BAR; PG8_WAIT_L(0); PG8_MMA(1, 0, At, B0); PG8_BAR; PG8_SCHED;
            PG8_STAGE(PG8_SB(0, 1), b2 + hstep, voffB);
            PG8_WAIT_V(6); PG8_BAR; PG8_MMA(1, 1, At, B1); PG8_BAR;
            PG8_LDB(B0, 1, 0); PG8_SCHED; PG8_LDA(At, 1, 0); PG8_STAGE(PG8_SA(0, 1), a2 + hstep, voffA);
            PG8_WAIT_L(8); PG8_BAR; PG8_WAIT_L(0); PG8_MMA(0, 0, At, B0); PG8_BAR; PG8_SCHED;
            PG8_LDB(B1, 1, 1); PG8_STAGE(PG8_SB(1, 0), b3, voffB);
            PG8_BAR; PG8_WAIT_L(0); PG8_MMA(0, 1, At, B1); PG8_BAR;
            PG8_LDA(At, 1, 1); PG8_STAGE(PG8_SA(1, 0), a3, voffA);
            PG8_BAR; PG8_WAIT_L(0); PG8_MMA(1, 0, At, B0); PG8_BAR; PG8_SCHED;
            PG8_STAGE(PG8_SB(1, 1), b3 + hstep, voffB);
            PG8_WAIT_V(6); PG8_BAR; PG8_MMA(1, 1, At, B1); PG8_BAR;
        }
        PG8_STAMP();
        if constexpr (!Epi::AFTER_DRAIN) { E(acc, cur, wr, wc, fr, fq); S.done(cur); }
        PG8_STAMP();
        if (!has_next) break;
        if (!(Epi::CHAIN && (cur.sel & 2)))
#pragma unroll
        for (int a = 0; a < 2; ++a)
#pragma unroll
            for (int b = 0; b < 2; ++b)
#pragma unroll
                for (int m = 0; m < 4; ++m)
#pragma unroll
                    for (int n = 0; n < 2; ++n) acc[a][b][m][n] = (f32x4){0.f, 0.f, 0.f, 0.f};
        cur = nxt; cA = nA; cB = nB; ++ui;
    }
    PG8_WAIT_V(0);
    if (wr == 0) PG8_BAR;
    PG8_BAR;
    if constexpr (Epi::AFTER_DRAIN) { E.fused(acc, cur, wr, wc, fr, fq, lds, wid, lane); S.done(cur); }
    PG8_STAMP();
    if (STAMP && wid == 0) { stamps[lane] = lane < nts ? (((unsigned long long)(unsigned)ts_hi << 32) | (unsigned)ts_lo) : 0ull;
        if (lane == 62) stamps[62] = rt_entry; if (lane == 63) stamps[63] = (unsigned long long)wall_clock64(); }
#undef PG8_STAMP
#undef PG8_SA
#undef PG8_SB
#undef PG8_STAGE
#undef PG8_LDA
#undef PG8_LDB
#undef PG8_MMA
#undef PG8_WAIT_V
#undef PG8_WAIT_L
#undef PG8_BAR
#undef PG8_SCHED
}
}
using pg8::bf16_t; using pg8::bf16x8; using pg8::f32x4; using pg8::u32x4; using pg8::Unit; using pg8::cvt_pk_bf16;
#define LAS __attribute__((address_space(3)))
typedef unsigned u32x2 __attribute__((ext_vector_type(2)));
typedef float f32x2 __attribute__((ext_vector_type(2)));

constexpr int D = 1024, TP = 32768, TS = 512, MT = TP + TS, NIN = 3840, FF = 2816, NMOD = 6144;
constexpr size_t MiB = 1u << 20;
constexpr size_t WS_MODS = 1 * MiB, WS_WIN = 5 * MiB, WS_WAO = 13 * MiB, WS_WCO = 14 * MiB, WS_WOUT = 15 * MiB, WS_WF1 = 17 * MiB, WS_WF2 = 28 * MiB,
                 WS_H = 34 * MiB, WS_Q = 99 * MiB, WS_K = 132 * MiB, WS_V = 141 * MiB, WS_U = 150 * MiB, WS_GA = 183 * MiB, WS_GC = 248 * MiB,
                 WS_ATT = 313 * MiB, WS_CV = 346 * MiB, WS_MM = 379 * MiB, WS_ACT = 99 * MiB, WS_END = 444 * MiB;
constexpr size_t O_YS = 33554432, O_KP = 34078720, O_VP = 34209792, O_CP = 34340864, O_KS = 34463744, O_VS = 36560896, O_CS = 38658048;
constexpr int LDS_BYTES = 147456;
constexpr int NPH = 10;

__device__ __forceinline__ float bf2f(unsigned short b) { return __uint_as_float(((unsigned)b) << 16); }
__device__ __forceinline__ float sigm(float x) { return __builtin_amdgcn_rcpf(1.0f + __builtin_amdgcn_exp2f(x * -1.4426950408889634f)); }
__device__ __forceinline__ float wave_sum(float v) {
#pragma unroll
    for (int o = 1; o < 64; o <<= 1) v += __shfl_xor(v, o);
    return v;
}
__device__ __forceinline__ float wave_max(float v) {
#pragma unroll
    for (int o = 1; o < 64; o <<= 1) v = fmaxf(v, __shfl_xor(v, o));
    return v;
}
__device__ __forceinline__ int mod_row(int r) { return r < TP ? (r >> 12) : 8 + ((r - TP) >> 2); }
__device__ __forceinline__ void unpack8(const u32x4 w, float (&f)[8]) {
    f[0] = __uint_as_float(w.x << 16); f[1] = __uint_as_float(w.x & 0xffff0000u); f[2] = __uint_as_float(w.y << 16); f[3] = __uint_as_float(w.y & 0xffff0000u);
    f[4] = __uint_as_float(w.z << 16); f[5] = __uint_as_float(w.z & 0xffff0000u); f[6] = __uint_as_float(w.w << 16); f[7] = __uint_as_float(w.w & 0xffff0000u);
}

struct Args { const float* in[23]; float* out; unsigned char* ws; int ph_lo, ph_hi; };
enum { I_XP = 0, I_XS, I_SK, I_SV, I_SC, I_CP, I_CS, I_N1, I_N2, I_WADA, I_BADA, I_WIN, I_SINKS, I_WAO, I_CONVW, I_CONVB, I_LNG, I_LNB, I_WCO, I_WOUT, I_WF1, I_WF2, I_FNG };

__device__ __forceinline__ void transpose_item(const float* W, int K, int N, bf16_t* WT, int which, LAS float* scr, int item, int lane) {
    const int nblk = N / 32, kb = item / nblk, nb = item % nblk, k0 = 64 * kb, n0 = 32 * nb;
    { f32x4 v[8]; const int kq = lane >> 3, n4 = (lane & 7) * 4;
#pragma unroll
      for (int i = 0; i < 8; ++i) v[i] = *(const f32x4*)(W + (size_t)(k0 + 8 * i + kq) * N + n0 + n4);
#pragma unroll
      for (int i = 0; i < 8; ++i) { LAS float* d = scr + (8 * i + kq) * 33 + n4; d[0] = v[i].x; d[1] = v[i].y; d[2] = v[i].z; d[3] = v[i].w; } }
    asm volatile("s_waitcnt lgkmcnt(0)" ::: "memory");
    int drow = n0;
    if (which == 1) { if (n0 >= 768 && n0 < 1280) { const int ch = n0 - 768; drow = 768 + 256 * (ch >> 7) + (ch & 127); } else if (n0 >= 1280 && n0 < 1792) { const int ch = n0 - 1280; drow = 768 + 256 * (ch >> 7) + 128 + (ch & 127); } }
    else if (which == 2) { if (n0 < FF) drow = 256 * (n0 >> 7) + (n0 & 127); else { const int ch = n0 - FF; drow = 256 * (ch >> 7) + 128 + (ch & 127); } }
    const int c = lane & 7;
#pragma unroll
    for (int j = 0; j < 4; ++j) { const int n = (lane >> 3) + 8 * j; const LAS float* s = scr + (8 * c) * 33 + n;
        u32x4 o; o.x = cvt_pk_bf16(s[0 * 33], s[1 * 33]); o.y = cvt_pk_bf16(s[2 * 33], s[3 * 33]); o.z = cvt_pk_bf16(s[4 * 33], s[5 * 33]); o.w = cvt_pk_bf16(s[6 * 33], s[7 * 33]);
        *(u32x4*)(WT + (size_t)(drow + n) * K + k0 + 8 * c) = o; }
    asm volatile("s_waitcnt lgkmcnt(0)" ::: "memory");
}

__device__ __forceinline__ void mods_item(LAS unsigned char* lds, const float* cp, const float* cs, const float* wada, const float* bada, float* mods, int item, int tid) {
    const int rg = item / 24, cb = item % 24;
    LAS float* sc = (LAS float*)lds;
    LAS float* red = (LAS float*)(lds + 81920);
    { float cvv[34];
#pragma unroll
      for (int i = 0; i < 34; ++i) { const int row = rg * 17 + (i >> 1); const float* src = row < 8 ? cp + row * 1024 : cs + (row - 8) * 1024; cvv[i] = src[tid + 512 * (i & 1)]; }
#pragma unroll
      for (int i = 0; i < 34; ++i) sc[(tid + 512 * (i & 1)) * 20 + (i >> 1)] = cvv[i] * sigm(cvv[i]); }
    __syncthreads();
    const int cq = tid & 63, ks = __builtin_amdgcn_readfirstlane(tid >> 6), col = cb * 256 + 4 * cq;
    f32x2 a01[17], a23[17];
#pragma unroll
    for (int r = 0; r < 17; ++r) { a01[r] = (f32x2){0.f, 0.f}; a23[r] = (f32x2){0.f, 0.f}; }
    const float* wp = wada + (size_t)(ks * 128) * NMOD + col;
#pragma unroll 8
    for (int k = 0; k < 128; ++k) {
        const f32x4 w4 = *(const f32x4*)(wp + (size_t)k * NMOD); const f32x2 wl = {w4.x, w4.y}, wh = {w4.z, w4.w};
        const LAS float* s = sc + (ks * 128 + k) * 20;
        const f32x4 s0 = *(const LAS f32x4*)s, s1 = *(const LAS f32x4*)(s + 4), s2 = *(const LAS f32x4*)(s + 8), s3 = *(const LAS f32x4*)(s + 12); const float s4 = s[16];
        const float sv[17] = {s0.x, s0.y, s0.z, s0.w, s1.x, s1.y, s1.z, s1.w, s2.x, s2.y, s2.z, s2.w, s3.x, s3.y, s3.z, s3.w, s4};
#pragma unroll
        for (int r = 0; r < 17; ++r) { const f32x2 sp = {sv[r], sv[r]}; a01[r] += sp * wl; a23[r] += sp * wh; }
    }
    __syncthreads();
    LAS f32x4* red4 = (LAS f32x4*)lds;
#pragma unroll
    for (int half = 4; half >= 1; half >>= 1) {
        if (ks >= half && ks < 2 * half) {
#pragma unroll
            for (int r = 0; r < 17; ++r) red4[((ks - half) * 17 + r) * 64 + cq] = (f32x4){a01[r].x, a01[r].y, a23[r].x, a23[r].y};
        }
        __syncthreads();
        if (ks < half) {
#pragma unroll
            for (int r = 0; r < 17; ++r) { const f32x4 p = red4[(ks * 17 + r) * 64 + cq]; a01[r] += (f32x2){p.x, p.y}; a23[r] += (f32x2){p.z, p.w}; }
        }
        __syncthreads();
    }
    if (ks == 0) { const f32x4 bb = *(const f32x4*)(bada + col);
#pragma unroll
        for (int r = 0; r < 17; ++r) *(f32x4*)(mods + (size_t)(rg * 17 + r) * NMOD + col) = (f32x4){a01[r].x, a01[r].y, a23[r].x, a23[r].y} + bb; }
    __syncthreads();
}

#define NT_ST(val, ptr) (*(ptr) = (val))
__device__ __forceinline__ void rows_norm_mod(const float* basep, const float* bases, const float* ng, const float* mods, int chunk_sh, bf16_t* H, float* copy_out, int gw, int ngw, int lane) {
    f32x4 v[4][4], nx[4][4];
    if (gw < MT / 4) { const int r0 = gw * 4; const float* xr = (r0 < TP ? basep + (size_t)r0 * D : bases + (size_t)(r0 - TP) * D) + 4 * lane;
#pragma unroll
        for (int rr = 0; rr < 4; ++rr)
#pragma unroll
            for (int j = 0; j < 4; ++j) nx[rr][j] = *(const f32x4*)(xr + (size_t)rr * D + 256 * j); }
    for (int wi = gw; wi < MT / 4; wi += ngw) {
        const int r0 = wi * 4; const float* mp = mods + (size_t)mod_row(r0) * NMOD + chunk_sh * 1024;
#pragma unroll
        for (int rr = 0; rr < 4; ++rr)
#pragma unroll
            for (int j = 0; j < 4; ++j) v[rr][j] = nx[rr][j];
        if (wi + ngw < MT / 4) { const int r1 = (wi + ngw) * 4; const float* xr = (r1 < TP ? basep + (size_t)r1 * D : bases + (size_t)(r1 - TP) * D) + 4 * lane;
#pragma unroll
            for (int rr = 0; rr < 4; ++rr)
#pragma unroll
                for (int j = 0; j < 4; ++j) nx[rr][j] = *(const f32x4*)(xr + (size_t)rr * D + 256 * j); }
        f32x4 gm[4], sh[4];
#pragma unroll
        for (int j = 0; j < 4; ++j) { const int c = 4 * lane + 256 * j; const f32x4 g = *(const f32x4*)(ng + c), s = *(const f32x4*)(mp + 1024 + c); gm[j] = g * (s + 1.0f); sh[j] = *(const f32x4*)(mp + c); }
#pragma unroll
        for (int rr = 0; rr < 4; ++rr) {
            const int r = r0 + rr; float ss = 0.f;
#pragma unroll
            for (int j = 0; j < 4; ++j) ss += (v[rr][j].x * v[rr][j].x + v[rr][j].y * v[rr][j].y) + (v[rr][j].z * v[rr][j].z + v[rr][j].w * v[rr][j].w);
            if (copy_out != nullptr && r >= TP) {
#pragma unroll
                for (int j = 0; j < 4; ++j) *(f32x4*)(copy_out + (size_t)r * D + 4 * lane + 256 * j) = v[rr][j]; }
            const float rinv = rsqrtf(wave_sum(ss) * (1.0f / D) + 1e-6f);
#pragma unroll
            for (int j = 0; j < 4; ++j) { const f32x4 o = v[rr][j] * rinv * gm[j] + sh[j]; u32x2 w; w.x = cvt_pk_bf16(o.x, o.y); w.y = cvt_pk_bf16(o.z, o.w);
                NT_ST(w, (u32x2*)(H + (size_t)r * D + 4 * lane + 256 * j)); }
        }
    }
}
__device__ __forceinline__ void rows_final(const float* in, float* out, const float* g, int gw, int ngw, int lane) {
    f32x4 gm[4];
#pragma unroll
    for (int j = 0; j < 4; ++j) gm[j] = *(const f32x4*)(g + 4 * lane + 256 * j);
    for (int wi = gw; wi < MT / 4; wi += ngw) {
        const float* xr = in + (size_t)wi * 4 * D + 4 * lane; float* orow = out + (size_t)wi * 4 * D + 4 * lane;
        f32x4 v[4][4];
#pragma unroll
        for (int rr = 0; rr < 4; ++rr)
#pragma unroll
            for (int j = 0; j < 4; ++j) v[rr][j] = (*(const f32x4*)(xr + (size_t)rr * D + 256 * j));
#pragma unroll
        for (int rr = 0; rr < 4; ++rr) {
            float ss = 0.f;
#pragma unroll
            for (int j = 0; j < 4; ++j) ss += (v[rr][j].x * v[rr][j].x + v[rr][j].y * v[rr][j].y) + (v[rr][j].z * v[rr][j].z + v[rr][j].w * v[rr][j].w);
            const float rinv = rsqrtf(wave_sum(ss) * (1.0f / D) + 1e-6f);
#pragma unroll
            for (int j = 0; j < 4; ++j) NT_ST(v[rr][j] * rinv * gm[j], (f32x4*)(orow + (size_t)rr * D + 256 * j));
        }
    }
}
__device__ __forceinline__ u32x4 pack8(const f32x4 a, const f32x4 b) { u32x4 w; w.x = cvt_pk_bf16(a.x, a.y); w.y = cvt_pk_bf16(a.z, a.w); w.z = cvt_pk_bf16(b.x, b.y); w.w = cvt_pk_bf16(b.z, b.w); return w; }

struct EpiIn {
    static constexpr bool PERM = true, AFTER_DRAIN = false, CHAIN = false;
    bf16_t *Q, *K, *V, *U, *GA, *GC; float* out;
    __device__ __forceinline__ void operator()(f32x4 (&acc)[2][2][4][2], const Unit& u, int wr, int wc, int fr, int fq) const {
        const int rowb = u.pm * 256 + wr * 64 + fr, cl = wc * 32 + 8 * fq, pn = u.pn;
        const bool sample = u.pm >= 128;
        if (pn <= 2) {
            const bool do_rope = (wc & 1) == 0;
            constexpr float INV_H[8] = {0.1591796875f, 0.0308837890625f, 0.0059814453125f, 0.00115966796875f, 0.000225067138671875f, 4.363059997558594e-05f, 8.463859558105469e-06f, 1.642853021621704e-06f};
            constexpr float INV_L[8] = {-2.474440771038644e-05f, -2.002565815928392e-05f, 3.7404001886898186e-06f, 9.956725079973694e-07f, 1.1940367805607366e-08f, 1.7352817849314306e-08f, 4.712501500137023e-10f, -1.4267588221983374e-09f};
#pragma unroll
            for (int ai = 0; ai < 2; ++ai)
#pragma unroll
                for (int m = 0; m < 4; ++m) {
                    const int r = rowb + ai * 128 + m * 16;
                    const int pos = sample ? 16384 + ((r - TP) & 3) : (r & 4095);
                    f32x4 v[2][2];
#pragma unroll
                    for (int bj = 0; bj < 2; ++bj)
#pragma unroll
                        for (int n = 0; n < 2; ++n) v[bj][n] = acc[ai][bj][m][n];
                    if (do_rope) {
#pragma unroll
                        for (int n = 0; n < 2; ++n)
#pragma unroll
                            for (int i = 0; i < 4; ++i) {
                                const float ph = (float)pos * INV_H[4 * n + i];
                                const float fx = (ph - __builtin_floorf(ph)) + (float)pos * INV_L[4 * n + i];
                                const float cs = __builtin_amdgcn_cosf(fx), sn = __builtin_amdgcn_sinf(fx);
#pragma unroll
                                for (int bj = 0; bj < 2; ++bj) {
                                    if (bj == 1 && pn == 2) continue;
                                    const float mine = v[bj][n][i], other = __shfl_xor(mine, 16);
                                    const float rot = (fq == 0) ? (mine * cs - other * sn) : (mine * cs + other * sn);
                                    v[bj][n][i] = (fq < 2) ? rot : mine;
                                }
                            }
                    }
                    if (pn < 2) {
#pragma unroll
                        for (int bj = 0; bj < 2; ++bj) NT_ST((u32x4)(pack8(v[bj][0] * 0.125f, v[bj][1] * 0.125f)), (u32x4*)(Q + (size_t)r * 512 + pn * 256 + bj * 128 + cl));
                    } else {
                        NT_ST((u32x4)(pack8(v[0][0], v[0][1])), (u32x4*)(K + (size_t)r * 128 + cl));
                        NT_ST((u32x4)(pack8(v[1][0], v[1][1])), (u32x4*)(V + (size_t)r * 128 + cl));
                        if (!sample) { const int t = r & 4095;
                            if (t >= 3968) { const size_t o = ((size_t)((r >> 12) * 128 + t - 3968)) * 128 + cl;
                                NT_ST((f32x4)(v[0][0]), (f32x4*)(out + O_KP + o)); NT_ST((f32x4)(v[0][1]), (f32x4*)(out + O_KP + o + 4)); NT_ST((f32x4)(v[1][0]), (f32x4*)(out + O_VP + o)); NT_ST((f32x4)(v[1][1]), (f32x4*)(out + O_VP + o + 4)); }
                        } else { const int bs = (r - TP) >> 2, t = (r - TP) & 3; const size_t o = ((size_t)(bs * 128 + 124 + t)) * 128 + cl;
                            NT_ST((f32x4)(v[0][0]), (f32x4*)(out + O_KS + o)); NT_ST((f32x4)(v[0][1]), (f32x4*)(out + O_KS + o + 4)); NT_ST((f32x4)(v[1][0]), (f32x4*)(out + O_VS + o)); NT_ST((f32x4)(v[1][1]), (f32x4*)(out + O_VS + o + 4)); }
                    }
                }
        } else if (pn <= 6) {
            const int chb = 128 * (pn - 3) + cl;
#pragma unroll
            for (int ai = 0; ai < 2; ++ai)
#pragma unroll
                for (int m = 0; m < 4; ++m) {
                    const int r = rowb + ai * 128 + m * 16;
                    f32x4 uu[2];
#pragma unroll
                    for (int n = 0; n < 2; ++n)
#pragma unroll
                        for (int i = 0; i < 4; ++i) uu[n][i] = acc[ai][0][m][n][i] * sigm(acc[ai][1][m][n][i]);
                    NT_ST((u32x4)(pack8(uu[0], uu[1])), (u32x4*)(U + (size_t)r * 512 + chb));
                    if (!sample) { const int t = r & 4095;
                        if (t >= 4066) { const size_t o = ((size_t)((r >> 12) * 30 + t - 4066)) * 512 + chb; NT_ST((f32x4)(uu[0]), (f32x4*)(out + O_CP + o)); NT_ST((f32x4)(uu[1]), (f32x4*)(out + O_CP + o + 4)); }
                    } else { const int bs = (r - TP) >> 2, t = (r - TP) & 3; const size_t o = ((size_t)(bs * 30 + 26 + t)) * 512 + chb; NT_ST((f32x4)(uu[0]), (f32x4*)(out + O_CS + o)); NT_ST((f32x4)(uu[1]), (f32x4*)(out + O_CS + o + 4)); }
                }
        } else {
            bf16_t* G = pn < 11 ? GA : GC; const int cb = 256 * ((pn - 7) & 3) + cl;
#pragma unroll
            for (int ai = 0; ai < 2; ++ai)
#pragma unroll
                for (int m = 0; m < 4; ++m) {
                    const int r = rowb + ai * 128 + m * 16;
#pragma unroll
                    for (int bj = 0; bj < 2; ++bj) { f32x4 a = acc[ai][bj][m][0], b = acc[ai][bj][m][1];
#pragma unroll
                        for (int i = 0; i < 4; ++i) { a[i] = sigm(a[i]); b[i] = sigm(b[i]); }
                        NT_ST((u32x4)(pack8(a, b)), (u32x4*)(G + (size_t)r * D + cb + bj * 128)); }
                }
        }
    }
};

template <int MODE> struct EpiGate {
    static constexpr bool PERM = true, AFTER_DRAIN = false, CHAIN = false;
    const bf16_t* G; bf16_t* MM;
    __device__ __forceinline__ void operator()(f32x4 (&acc)[2][2][4][2], const Unit& u, int wr, int wc, int fr, int fq) const {
        const int rowb = u.pm * 256 + wr * 64 + fr, cb = u.pn * 256 + wc * 32 + 8 * fq;
#pragma unroll
        for (int ai = 0; ai < 2; ++ai)
#pragma unroll
            for (int m = 0; m < 4; ++m) {
                const size_t ro = (size_t)(rowb + ai * 128 + m * 16) * D + cb;
#pragma unroll
                for (int bj = 0; bj < 2; ++bj) {
                    float g[8]; unpack8(*(const u32x4*)(G + ro + bj * 128), g);
                    f32x4 a = acc[ai][bj][m][0], b = acc[ai][bj][m][1];
                    a.x *= g[0]; a.y *= g[1]; a.z *= g[2]; a.w *= g[3]; b.x *= g[4]; b.y *= g[5]; b.z *= g[6]; b.w *= g[7];
                    if (MODE == 1) { float p[8]; unpack8(*(const u32x4*)(MM + ro + bj * 128), p); a.x += p[0]; a.y += p[1]; a.z += p[2]; a.w += p[3]; b.x += p[4]; b.y += p[5]; b.z += p[6]; b.w += p[7]; }
                    NT_ST((u32x4)(pack8(a, b)), (u32x4*)(MM + ro + bj * 128));
                }
            }
    }
};

struct MergeOrder {
    pg8::StaticOrder P;
    __device__ __forceinline__ void init(int G_, int c_) { P.init(TP, D, 512, G_, c_); }
    __device__ __forceinline__ bool next(int i, Unit& u) const { const bool ok = P.next(i >> 1, u); u.sel = (i & 1) ? 1 : 2; return ok; }
    __device__ __forceinline__ void a_ready(const Unit&) const {}
    __device__ __forceinline__ void done(const Unit&) const {}
};
struct SampleHalfOrder {
    int G, c;
    __device__ __forceinline__ void init(int G_, int c_) { G = G_; c = c_; }
    __device__ __forceinline__ bool next(int i, Unit& u) const { const int h = i * G + c, tile = h >> 1; u.pm = 128 + (tile >> 2); u.pn = tile & 3; u.k0 = 0; u.nt = 8; u.sel = h & 1; return h < 16; }
    __device__ __forceinline__ void a_ready(const Unit&) const {}
    __device__ __forceinline__ void done(const Unit&) const {}
};
struct EpiHalf {
    static constexpr bool PERM = true, AFTER_DRAIN = false, CHAIN = false;
    const bf16_t* GA; const bf16_t* GC; bf16_t* MM; bf16_t* PBv;
    __device__ __forceinline__ void operator()(f32x4 (&acc)[2][2][4][2], const Unit& u, int wr, int wc, int fr, int fq) const {
        const int rowb = u.pm * 256 + wr * 64 + fr, cb = u.pn * 256 + wc * 32 + 8 * fq;
        const bf16_t* Gt = (u.sel & 1) ? GC : GA; bf16_t* dst = (u.sel & 1) ? PBv : MM;
#pragma unroll
        for (int ai = 0; ai < 2; ++ai) {
            u32x4 wg[4][2];
#pragma unroll
            for (int m = 0; m < 4; ++m)
#pragma unroll
                for (int bj = 0; bj < 2; ++bj) wg[m][bj] = *(const u32x4*)(Gt + (size_t)(rowb + ai * 128 + m * 16) * D + cb + bj * 128);
#pragma unroll
            for (int m = 0; m < 4; ++m)
#pragma unroll
                for (int bj = 0; bj < 2; ++bj) {
                    float gg[8]; unpack8(wg[m][bj], gg);
                    f32x4 a = acc[ai][bj][m][0], b = acc[ai][bj][m][1];
                    a.x *= gg[0]; a.y *= gg[1]; a.z *= gg[2]; a.w *= gg[3]; b.x *= gg[4]; b.y *= gg[5]; b.z *= gg[6]; b.w *= gg[7];
                    *(u32x4*)(dst + (size_t)(rowb + ai * 128 + m * 16) * D + cb + bj * 128) = pack8(a, b);
                }
        }
    }
};
struct EpiMerge {
    static constexpr bool PERM = true, AFTER_DRAIN = false, CHAIN = true;
    const bf16_t* GA; const bf16_t* GC; bf16_t* MM;
    __device__ __forceinline__ void operator()(f32x4 (&acc)[2][2][4][2], const Unit& u, int wr, int wc, int fr, int fq) const {
        const int rowb = u.pm * 256 + wr * 64 + fr, cb = u.pn * 256 + wc * 32 + 8 * fq;
        if ((u.sel & 1) == 0) {
#pragma unroll
            for (int ai = 0; ai < 2; ++ai) {
                u32x4 wa[4][2], wc_[4][2];
#pragma unroll
                for (int m = 0; m < 4; ++m)
#pragma unroll
                    for (int bj = 0; bj < 2; ++bj) { const size_t ro = (size_t)(rowb + ai * 128 + m * 16) * D + cb + bj * 128; wa[m][bj] = *(const u32x4*)(GA + ro); wc_[m][bj] = *(const u32x4*)(GC + ro); }
#pragma unroll
                for (int m = 0; m < 4; ++m)
#pragma unroll
                    for (int bj = 0; bj < 2; ++bj) {
                        float ga[8], gc[8]; unpack8(wa[m][bj], ga); unpack8(wc_[m][bj], gc);
#pragma unroll
                        for (int i = 0; i < 4; ++i) { acc[ai][bj][m][0][i] *= ga[i] * __builtin_amdgcn_rcpf(gc[i]); acc[ai][bj][m][1][i] *= ga[4 + i] * __builtin_amdgcn_rcpf(gc[4 + i]); }
                    }
            }
        } else {
#pragma unroll
            for (int ai = 0; ai < 2; ++ai) {
                u32x4 wc_[4][2];
#pragma unroll
                for (int m = 0; m < 4; ++m)
#pragma unroll
                    for (int bj = 0; bj < 2; ++bj) wc_[m][bj] = *(const u32x4*)(GC + (size_t)(rowb + ai * 128 + m * 16) * D + cb + bj * 128);
#pragma unroll
                for (int m = 0; m < 4; ++m)
#pragma unroll
                    for (int bj = 0; bj < 2; ++bj) {
                        float gc[8]; unpack8(wc_[m][bj], gc);
                        f32x4 a = acc[ai][bj][m][0], b = acc[ai][bj][m][1];
                        a.x *= gc[0]; a.y *= gc[1]; a.z *= gc[2]; a.w *= gc[3]; b.x *= gc[4]; b.y *= gc[5]; b.z *= gc[6]; b.w *= gc[7];
                        *(u32x4*)(MM + (size_t)(rowb + ai * 128 + m * 16) * D + cb + bj * 128) = pack8(a, b);
                    }
            }
        }
    }
};
struct EpiRes {
    static constexpr bool PERM = false, AFTER_DRAIN = false, CHAIN = false;
    const float* basep; const float* gate; float* out;
    __device__ __forceinline__ void operator()(f32x4 (&acc)[2][2][4][2], const Unit& u, int wr, int wc, int fr, int fq) const {
        const int rowb = u.pm * 256 + wr * 64 + fr, cb = u.pn * 256 + wc * 32 + 4 * fq;
        if (u.pm < 128) {
            const float* gr = gate + (size_t)(u.pm >> 4) * NMOD + cb;
            f32x4 gv[2][2];
#pragma unroll
            for (int bj = 0; bj < 2; ++bj)
#pragma unroll
                for (int n = 0; n < 2; ++n) gv[bj][n] = *(const f32x4*)(gr + bj * 128 + n * 16);
#pragma unroll
            for (int ai = 0; ai < 2; ++ai) {
                f32x4 bs[4][2][2];
#pragma unroll
                for (int m = 0; m < 4; ++m)
#pragma unroll
                    for (int bj = 0; bj < 2; ++bj)
#pragma unroll
                        for (int n = 0; n < 2; ++n) bs[m][bj][n] = *(const f32x4*)(basep + (size_t)(rowb + ai * 128 + m * 16) * D + cb + bj * 128 + n * 16);
#pragma unroll
                for (int m = 0; m < 4; ++m)
#pragma unroll
                    for (int bj = 0; bj < 2; ++bj)
#pragma unroll
                        for (int n = 0; n < 2; ++n) *(f32x4*)(out + (size_t)(rowb + ai * 128 + m * 16) * D + cb + bj * 128 + n * 16) = bs[m][bj][n] + gv[bj][n] * acc[ai][bj][m][n];
            }
        } else {
#pragma unroll
            for (int ai = 0; ai < 2; ++ai) {
                f32x4 gs[4][2][2];
#pragma unroll
                for (int m = 0; m < 4; ++m) { const float* gr = gate + (size_t)mod_row(rowb + ai * 128 + m * 16) * NMOD + cb;
#pragma unroll
                    for (int bj = 0; bj < 2; ++bj)
#pragma unroll
                        for (int n = 0; n < 2; ++n) gs[m][bj][n] = *(const f32x4*)(gr + bj * 128 + n * 16); }
#pragma unroll
                for (int m = 0; m < 4; ++m) { float* orow = out + (size_t)(rowb + ai * 128 + m * 16) * D + cb;
#pragma unroll
                    for (int bj = 0; bj < 2; ++bj)
#pragma unroll
                        for (int n = 0; n < 2; ++n) { const int o = bj * 128 + n * 16; const f32x4 v = gs[m][bj][n] * acc[ai][bj][m][n];
                            unsafeAtomicAdd(orow + o, v.x); unsafeAtomicAdd(orow + o + 1, v.y); unsafeAtomicAdd(orow + o + 2, v.z); unsafeAtomicAdd(orow + o + 3, v.w); } }
            }
        }
    }
};
template <int DUAL> struct TailSplitOrder {
    pg8::StaticOrder P; int G, c, S, ntk;
    __device__ __forceinline__ void init(int K, int S_, int G_, int c_) { P.init(TP, D, K, G_, c_); G = G_; c = c_; S = S_; ntk = K / 64; }
    __device__ __forceinline__ bool next(int i, Unit& u) const {
        const int L = i * G + c; const bool isp = L < 512;
        Unit p; const bool okp = P.next(i, p);
        const int ST = DUAL ? 2 * S : S;
        const int idx = L - 512, tile = idx / ST, sl = idx - tile * ST, ns = ntk / S, half = sl >= S ? 1 : 0, sk = sl - half * S;
        u.pm = isp ? p.pm : 128 + (tile >> 2); u.pn = isp ? p.pn : (tile & 3); u.nt = isp ? ntk : ns; u.k0 = isp ? 0 : sk * ns * 64; u.sel = isp ? 0 : half;
        return isp ? okp : (idx < 8 * ST);
    }
    __device__ __forceinline__ void a_ready(const Unit&) const {}
    __device__ __forceinline__ void done(const Unit&) const {}
};

struct EpiSwi {
    static constexpr bool PERM = true, AFTER_DRAIN = false, CHAIN = false;
    bf16_t* ACT;
    __device__ __forceinline__ void operator()(f32x4 (&acc)[2][2][4][2], const Unit& u, int wr, int wc, int fr, int fq) const {
        const int rowb = u.pm * 256 + wr * 64 + fr, cb = u.pn * 128 + wc * 32 + 8 * fq;
#pragma unroll
        for (int ai = 0; ai < 2; ++ai)
#pragma unroll
            for (int m = 0; m < 4; ++m) {
                f32x4 uu[2];
#pragma unroll
                for (int n = 0; n < 2; ++n)
#pragma unroll
                    for (int i = 0; i < 4; ++i) { const float g = acc[ai][0][m][n][i]; uu[n][i] = g * sigm(g) * acc[ai][1][m][n][i]; }
                NT_ST((u32x4)(pack8(uu[0], uu[1])), (u32x4*)(ACT + (size_t)(rowb + ai * 128 + m * 16) * FF + cb));
            }
    }
};
#define MFMA16(a, b, c) __builtin_amdgcn_mfma_f32_16x16x32_bf16((a), (b), (c), 0, 0, 0)
constexpr int ATT_VT_OFF = 39168, SATT_OFF = 77824, CONV_RED_OFF = 110592;
__device__ __forceinline__ void attn_prompt_item(LAS unsigned char* lds, const bf16_t* Q, const bf16_t* Kb, const bf16_t* Vb, bf16_t* ATT, const float* sinks, int item, int tid) {
    const int b = item >> 6, blk = (item >> 1) & 31, kvh = item & 1;
    const int tok0 = b * 4096 + blk * 128;
    LAS bf16_t* Ks = (LAS bf16_t*)lds;
    LAS bf16_t* Vt = (LAS bf16_t*)(lds + ATT_VT_OFF);
    { u32x4 kva[4], vva[4];
#pragma unroll
      for (int it = 0; it < 4; ++it) { const int c = tid + it * 512, key = c >> 3, part = c & 7; const bool ok = blk > 0 || key >= 128;
          const size_t g = (size_t)(ok ? tok0 - 128 + key : tok0) * 128 + kvh * 64 + part * 8; kva[it] = *(const u32x4*)(Kb + g); vva[it] = *(const u32x4*)(Vb + g); }
#pragma unroll
      for (int it = 0; it < 4; ++it) { const int c = tid + it * 512, key = c >> 3, part = c & 7; const bool ok = blk > 0 || key >= 128;
          const u32x4 z = {0u, 0u, 0u, 0u}; const u32x4 kv = ok ? kva[it] : z, vv = ok ? vva[it] : z;
          *(LAS u32x4*)(Ks + key * 72 + part * 8) = kv;
          LAS bf16_t* vp = Vt + (part * 8) * 280 + key;
          vp[0 * 280] = (bf16_t)(vv.x & 0xffffu); vp[1 * 280] = (bf16_t)(vv.x >> 16); vp[2 * 280] = (bf16_t)(vv.y & 0xffffu); vp[3 * 280] = (bf16_t)(vv.y >> 16);
          vp[4 * 280] = (bf16_t)(vv.z & 0xffffu); vp[5 * 280] = (bf16_t)(vv.z >> 16); vp[6 * 280] = (bf16_t)(vv.w & 0xffffu); vp[7 * 280] = (bf16_t)(vv.w >> 16); } }
    for (int i = tid; i < 576; i += 512) ((LAS unsigned*)(Ks + 256 * 72))[i] = 0u;
    for (int i = tid; i < 1536; i += 512) { const int r = i / 24, c = i % 24; Vt[r * 280 + 256 + c] = 0; }
    const int w = tid >> 6, lane = tid & 63, l15 = lane & 15, q4 = lane >> 4;
    const int h = kvh * 4 + (w >> 1), qh = w & 1;
    bf16x8 qfa[4][2];
#pragma unroll
    for (int qt = 0; qt < 4; ++qt) { const bf16_t* qp = Q + (size_t)(tok0 + qh * 64 + qt * 16 + l15) * 512 + h * 64 + 8 * q4; qfa[qt][0] = *(const bf16x8*)qp; qfa[qt][1] = *(const bf16x8*)(qp + 32); }
    __syncthreads();
    const float sink = sinks[h];
#pragma unroll
    for (int qt = 0; qt < 4; ++qt) {
        const int qi0 = qh * 64 + qt * 16;
        const bf16x8 qf0 = qfa[qt][0], qf1 = qfa[qt][1];
        f32x4 s[10];
#pragma unroll
        for (int kt = 0; kt < 9; ++kt) {
            const LAS bf16_t* kp = Ks + (qi0 + 16 * kt + l15) * 72 + 8 * q4;
            const bf16x8 a0 = *(const LAS bf16x8*)kp, a1 = *(const LAS bf16x8*)(kp + 32);
            f32x4 z = {0.f, 0.f, 0.f, 0.f};
            z = MFMA16(a0, qf0, z); s[kt] = MFMA16(a1, qf1, z);
        }
        s[9] = (f32x4){0.f, 0.f, 0.f, 0.f};
        float mx = sink;
#pragma unroll
        for (int kt = 0; kt < 9; ++kt)
#pragma unroll
            for (int i = 0; i < 4; ++i) {
                const int rel = 16 * kt + 4 * q4 + i - l15;
                const bool valid = rel >= 1 && rel <= 128 && (blk > 0 || (qi0 + 16 * kt + 4 * q4 + i) >= 128);
                const float sv = valid ? s[kt][i] : -1e30f; s[kt][i] = sv; mx = fmaxf(mx, sv);
            }
        mx = fmaxf(mx, __shfl_xor(mx, 16)); mx = fmaxf(mx, __shfl_xor(mx, 32));
        float sum = 0.f;
#pragma unroll
        for (int kt = 0; kt < 9; ++kt)
#pragma unroll
            for (int i = 0; i < 4; ++i) { const float p = __expf(s[kt][i] - mx); s[kt][i] = p; sum += p; }
        sum += __shfl_xor(sum, 16); sum += __shfl_xor(sum, 32);
        const float inv = 1.0f / (sum + __expf(sink - mx));
        bf16x8 pb[5];
#pragma unroll
        for (int kp = 0; kp < 5; ++kp) pb[kp] = __builtin_bit_cast(bf16x8, pack8(s[2 * kp], s[2 * kp + 1]));
        f32x4 o[4];
#pragma unroll
        for (int dt = 0; dt < 4; ++dt) {
            o[dt] = (f32x4){0.f, 0.f, 0.f, 0.f};
#pragma unroll
            for (int kp = 0; kp < 5; ++kp) {
                const LAS bf16_t* vp = Vt + (dt * 16 + l15) * 280 + qi0 + 32 * kp + 4 * q4;
                const u32x2 lo = *(const LAS u32x2*)vp, hi = *(const LAS u32x2*)(vp + 16);
                u32x4 av; av.x = lo.x; av.y = lo.y; av.z = hi.x; av.w = hi.y;
                o[dt] = MFMA16(__builtin_bit_cast(bf16x8, av), pb[kp], o[dt]);
            }
        }
        bf16_t* op = ATT + (size_t)(tok0 + qi0 + l15) * 512 + h * 64 + 4 * q4;
#pragma unroll
        for (int dt = 0; dt < 4; ++dt) { u32x2 wv; wv.x = cvt_pk_bf16(o[dt].x * inv, o[dt].y * inv); wv.y = cvt_pk_bf16(o[dt].z * inv, o[dt].w * inv); *(u32x2*)(op + dt * 16) = wv; }
    }
    __syncthreads();
}

__device__ __forceinline__ void attn_sample_item(LAS unsigned char* ldsw, const bf16_t* Q, const bf16_t* Kb, const bf16_t* Vb, const float* sk, const float* sv, bf16_t* ATT, const float* sinks, int item, int lane) {
    const int b = item >> 3, h = item & 7, kvh = h >> 2, rowb = TP + b * 4;
    LAS float* qs = (LAS float*)ldsw;
    LAS float* ps = (LAS float*)(ldsw + 1024);
#pragma unroll
    for (int t = 0; t < 4; ++t) qs[t * 64 + lane] = bf2f(Q[(size_t)(rowb + t) * 512 + h * 64 + lane]);
    asm volatile("s_waitcnt lgkmcnt(0)" ::: "memory");
    float sc[3][4];
#pragma unroll
    for (int t = 0; t < 4; ++t) sc[2][t] = 0.f;
#pragma unroll
    for (int sl = 0; sl < 2; ++sl) {
        const int j = lane + 64 * sl; const float* kp = sk + ((size_t)(b * 128 + j) * 2 + kvh) * 64;
        float s0 = 0.f, s1 = 0.f, s2 = 0.f, s3 = 0.f;
#pragma unroll 1
        for (int c = 0; c < 16; c += 8) {
            f32x4 kk[8];
#pragma unroll
            for (int cc = 0; cc < 8; ++cc) kk[cc] = *(const f32x4*)(kp + 4 * (c + cc));
#pragma unroll
            for (int cc = 0; cc < 8; ++cc) { const f32x4 k4 = kk[cc]; const LAS float* qq = qs + 4 * (c + cc);
                const f32x4 q0 = *(const LAS f32x4*)(qq), q1 = *(const LAS f32x4*)(qq + 64), q2 = *(const LAS f32x4*)(qq + 128), q3 = *(const LAS f32x4*)(qq + 192);
                s0 += (k4.x * q0.x + k4.y * q0.y) + (k4.z * q0.z + k4.w * q0.w); s1 += (k4.x * q1.x + k4.y * q1.y) + (k4.z * q1.z + k4.w * q1.w);
                s2 += (k4.x * q2.x + k4.y * q2.y) + (k4.z * q2.z + k4.w * q2.w); s3 += (k4.x * q3.x + k4.y * q3.y) + (k4.z * q3.z + k4.w * q3.w); }
        }
        sc[sl][0] = s0; sc[sl][1] = s1; sc[sl][2] = s2; sc[sl][3] = s3;
        asm volatile("" ::: "memory");
    }
    if (lane < 4) { const bf16_t* kp = Kb + (size_t)(rowb + lane) * 128 + kvh * 64;
        u32x2 kn[16];
#pragma unroll
        for (int c = 0; c < 16; ++c) kn[c] = *(const u32x2*)(kp + 4 * c);
#pragma unroll
        for (int c = 0; c < 16; ++c) { const u32x2 kk = kn[c];
            const float k0 = __uint_as_float(kk.x << 16), k1 = __uint_as_float(kk.x & 0xffff0000u), k2 = __uint_as_float(kk.y << 16), k3 = __uint_as_float(kk.y & 0xffff0000u);
#pragma unroll
            for (int t = 0; t < 4; ++t) { const f32x4 q4 = *(const LAS f32x4*)(qs + t * 64 + 4 * c); sc[2][t] += (k0 * q4.x + k1 * q4.y) + (k2 * q4.z + k3 * q4.w); } }
    }
    const float sink = sinks[h];
    float den[4];
#pragma unroll
    for (int t = 0; t < 4; ++t) {
        float mx = sink; bool vd[3];
#pragma unroll
        for (int sl = 0; sl < 3; ++sl) { const int j = lane + 64 * sl; vd[sl] = (j >= t + 1) && (j <= t + 128) && (j < 132); if (vd[sl]) mx = fmaxf(mx, sc[sl][t]); }
        mx = wave_max(mx);
        float sum = 0.f;
#pragma unroll
        for (int sl = 0; sl < 3; ++sl) { const int j = lane + 64 * sl; const float p = vd[sl] ? __expf(sc[sl][t] - mx) : 0.f; sum += p; if (j < 132) ps[t * 132 + j] = p; }
        sum = wave_sum(sum);
        den[t] = sum + __expf(sink - mx);
    }
    asm volatile("s_waitcnt lgkmcnt(0)" ::: "memory");
    float o[4] = {0.f, 0.f, 0.f, 0.f};
    const float* vp = sv + ((size_t)(b * 128) * 2 + kvh) * 64 + lane;
#pragma unroll 1
    for (int j0 = 0; j0 < 128; j0 += 32) {
        float vv[32];
#pragma unroll
        for (int jj = 0; jj < 32; ++jj) vv[jj] = vp[(size_t)(j0 + jj) * 128];
        asm volatile("" ::: "memory");
#pragma unroll
        for (int jj = 0; jj < 32; ++jj)
#pragma unroll
            for (int t = 0; t < 4; ++t) o[t] += ps[t * 132 + j0 + jj] * vv[jj];
    }
#pragma unroll
    for (int j = 0; j < 4; ++j) { const float v = bf2f(Vb[(size_t)(rowb + j) * 128 + kvh * 64 + lane]);
#pragma unroll
        for (int t = 0; t < 4; ++t) o[t] += ps[t * 132 + 128 + j] * v; }
#pragma unroll
    for (int t = 0; t < 4; ++t) ATT[(size_t)(rowb + t) * 512 + h * 64 + lane] = (bf16_t)(cvt_pk_bf16(o[t] / den[t], 0.f) & 0xffffu);
    asm volatile("s_waitcnt lgkmcnt(0)" ::: "memory");
}

template <int T, bool SAMPLE>
__device__ __forceinline__ void conv_phase(LAS unsigned char* lds, const bf16_t* U, const float* state_conv, const float* cw, const float* cb, const float* lng, const float* lnb, bf16_t* CV, int it0, int nit, int stride, int tid) {
    if (it0 >= nit) return;
    const int cp = tid & 255, c0 = 2 * cp, th = __builtin_amdgcn_readfirstlane(tid >> 8), wv = __builtin_amdgcn_readfirstlane(tid >> 6), lane = tid & 63;
    float w0[31], w1[31];
#pragma unroll
    for (int j = 0; j < 31; ++j) { const f32x2 ww = *(const f32x2*)(cw + j * 512 + c0); w0[j] = ww.x; w1[j] = ww.y; }
    const f32x2 bias = *(const f32x2*)(cb + c0), gg = *(const f32x2*)(lng + c0), bb2 = *(const f32x2*)(lnb + c0);
    const unsigned* Uc = (const unsigned*)U + cp;
    const f32x2* Sc = (const f32x2*)state_conv + cp;
    unsigned* CVc = (unsigned*)CV + cp;
    LAS float* red = (LAS float*)(lds + CONV_RED_OFF);
    unsigned praw[T + 30];
    if (!SAMPLE) { const int rowf = it0 * 16 + th * 8, tl0 = rowf & 4095;
#pragma unroll
        for (int si = 0; si < T + 30; ++si) { const bool ok = tl0 + si - 30 >= 0; praw[si] = Uc[(size_t)(ok ? rowf + si - 30 : rowf) * 256]; } }
    for (int item = it0; item < nit; item += stride) {
        int rowf, tl0 = 0, bs = 0;
        if (SAMPLE) { bs = item * 2 + th; rowf = TP + bs * 4; }
        else { rowf = item * 16 + th * 8; tl0 = rowf & 4095; }
        f32x2 ac[T];
#pragma unroll
        for (int t = 0; t < T; ++t) ac[t] = bias;
        float u0a[T + 30], u1a[T + 30];
#pragma unroll
        for (int si = 0; si < T + 30; ++si) {
            if (SAMPLE) {
                if (si < 30) { const f32x2 uu = Sc[(size_t)(bs * 30 + si) * 256]; u0a[si] = uu.x; u1a[si] = uu.y; }
                else { const unsigned uu = Uc[(size_t)(rowf + si - 30) * 256]; u0a[si] = __uint_as_float(uu << 16); u1a[si] = __uint_as_float(uu & 0xffff0000u); }
            } else {
                const bool ok = tl0 + si - 30 >= 0; const unsigned uu = praw[si]; u0a[si] = ok ? __uint_as_float(uu << 16) : 0.f; u1a[si] = ok ? __uint_as_float(uu & 0xffff0000u) : 0.f;
            }
        }
        asm volatile("" ::: "memory");
        if (!SAMPLE && item + stride < nit) { const int rown = (item + stride) * 16 + th * 8, tln = rown & 4095;
#pragma unroll
            for (int si = 0; si < T + 30; ++si) { const bool ok = tln + si - 30 >= 0; praw[si] = Uc[(size_t)(ok ? rown + si - 30 : rown) * 256]; } }
#pragma unroll
        for (int si = 0; si < T + 30; ++si) {
#pragma unroll
            for (int t = 0; t < T; ++t) { const int j = si - t; if (j >= 0 && j <= 30) ac[t] += (f32x2){w0[j], w1[j]} * (f32x2){u0a[si], u1a[si]}; }
        }
        { float rs[2 * T];
#pragma unroll
          for (int t = 0; t < T; ++t) { rs[2 * t] = ac[t].x + ac[t].y; rs[2 * t + 1] = ac[t].x * ac[t].x + ac[t].y * ac[t].y; }
#pragma unroll
          for (int o = 1; o < 64; o <<= 1) { float tmp[2 * T];
#pragma unroll
              for (int q = 0; q < 2 * T; ++q) tmp[q] = __shfl_xor(rs[q], o);
#pragma unroll
              for (int q = 0; q < 2 * T; ++q) rs[q] += tmp[q]; }
          if (lane == 0) {
#pragma unroll
              for (int q = 0; q < 2 * T; ++q) red[wv * 2 * T + q] = rs[q]; } }
        __syncthreads();
#pragma unroll
        for (int t = 0; t < T; ++t) {
            float s1 = 0.f, s2 = 0.f;
#pragma unroll
            for (int k = 0; k < 4; ++k) { s1 += red[(th * 4 + k) * 2 * T + 2 * t]; s2 += red[(th * 4 + k) * 2 * T + 2 * t + 1]; }
            const float mean = s1 * (1.0f / 512.0f), var = fmaxf(s2 * (1.0f / 512.0f) - mean * mean, 0.f), rstd = rsqrtf(var + 1e-5f);
            const float n0 = (ac[t].x - mean) * rstd * gg.x + bb2.x, n1 = (ac[t].y - mean) * rstd * gg.y + bb2.y;
            CVc[(size_t)(rowf + t) * 256] = cvt_pk_bf16(n0 * sigm(n0), n1 * sigm(n1));
        }
        __syncthreads();
    }
}
#define XB_TMO      128
#define XB_XCNT(j)  (256  + 64 * (j))
#define XB_XSUB(j)  (1280 + 64 * (j))
#define XB_XGEN(j)  (2304 + 64 * (j))
#define XB_TOP      3328
#define XB_TOPGEN   3392
#define XCD_BAR_WORDS 3456
#define XB_SPIN_CAP (1u << 18)

__device__ __forceinline__ unsigned xb_ld(unsigned* p)              { return __hip_atomic_load(p, __ATOMIC_RELAXED, __HIP_MEMORY_SCOPE_AGENT); }
__device__ __forceinline__ unsigned xb_add(unsigned* p, unsigned v) { return __hip_atomic_fetch_add(p, v, __ATOMIC_RELAXED, __HIP_MEMORY_SCOPE_AGENT); }
__device__ __forceinline__ unsigned xb_xcc_id() { return (unsigned)__builtin_amdgcn_s_getreg((3 << 11) | 20) & 0xFu; }
#define XB_SPIN(cond, bar) do { unsigned _sp = 0; while (cond) { __builtin_amdgcn_s_sleep(1); \
    if ((++_sp & 255u) == 0u) { if (xb_ld(&(bar)[XB_TMO])) break; if (_sp > XB_SPIN_CAP) { atomicAdd(&(bar)[XB_TMO], 1u); break; } } } } while (0)

struct XcdBarrier {
    unsigned* bar; unsigned x;
    volatile LAS unsigned* st;
};

__device__ __forceinline__ XcdBarrier xcd_barrier_post(unsigned* bar, volatile LAS unsigned* st) {
    XcdBarrier b; b.bar = bar; b.x = xb_xcc_id(); b.st = st;
    if (threadIdx.x == 0) (void)xb_add(&bar[XB_XCNT(b.x)], 1u);
    return b;
}
__device__ __forceinline__ void xcd_barrier_complete(unsigned* bar, unsigned x, unsigned& nloc, unsigned& nx) {
    const unsigned G = gridDim.x * gridDim.y * gridDim.z;
    unsigned sum, cnt, mine, sp = 0u;
    for (;;) {
        sum = 0u; cnt = 0u; mine = 0u;
#pragma unroll
        for (unsigned j = 0; j < 16; ++j) { const unsigned c = xb_ld(&bar[XB_XCNT(j)]); sum += c; cnt += (c > 0u) ? 1u : 0u; mine = (j == x) ? c : mine; }
        if (sum == G) break;
        __builtin_amdgcn_s_sleep(1);
        if ((++sp & 255u) == 0u) { if (xb_ld(&bar[XB_TMO])) break; if (sp > XB_SPIN_CAP) { atomicAdd(&bar[XB_TMO], 1u); break; } }
    }
    nloc = mine > 0u ? mine : 1u; nx = cnt > 0u ? cnt : 1u;
}

__device__ __forceinline__ void xcd_barrier(const XcdBarrier& b) {
    asm volatile("s_waitcnt vmcnt(0)" ::: "memory");
    __syncthreads();
    if (threadIdx.x == 0) {
        unsigned* bar = b.bar;
        __builtin_amdgcn_s_waitcnt(0);
        unsigned nloc = b.st[0], nx = b.st[1];
        if (nloc == 0u) { xcd_barrier_complete(bar, b.x, nloc, nx); b.st[0] = nloc; b.st[1] = nx; }
        const unsigned old = xb_add(&bar[XB_XSUB(b.x)], 1u);
        const unsigned gen = old / nloc;
        if (old + 1u == (gen + 1u) * nloc) {
            __builtin_amdgcn_fence(__ATOMIC_RELEASE, "agent");
            asm volatile("s_waitcnt vmcnt(0)" ::: "memory");
            const unsigned og = xb_add(&bar[XB_TOP], 1u);
            const unsigned tg = og / nx;
            if (og + 1u == (tg + 1u) * nx) xb_add(&bar[XB_TOPGEN], 1u);
            else XB_SPIN(xb_ld(&bar[XB_TOPGEN]) == tg, bar);
            __builtin_amdgcn_fence(__ATOMIC_ACQUIRE, "agent");
            xb_add(&bar[XB_XGEN(b.x)], 1u);
            asm volatile("s_waitcnt vmcnt(0)" ::: "memory");
        } else {
            XB_SPIN(xb_ld(&bar[XB_XGEN(b.x)]) == gen, bar);
            __builtin_amdgcn_fence(__ATOMIC_ACQUIRE, "agent");
            asm volatile("s_waitcnt vmcnt(0)" ::: "memory");
        }
    }
    __syncthreads();
}
constexpr int MISC_OFF = 131072 + 320;
__device__ __forceinline__ void stagger(int bid, unsigned step_ticks) {
    const unsigned long long t0 = __builtin_amdgcn_s_memrealtime();
    const unsigned long long d = (unsigned long long)(((unsigned)bid >> 3) & 7u) * step_ticks;
    while (__builtin_amdgcn_s_memrealtime() - t0 < d) __builtin_amdgcn_s_sleep(16);
}
#ifndef STG2
#define STG2 400
#endif
template <int LIM, bool FIRST>
__device__ __forceinline__ void program(const Args& a, LAS unsigned char* lds, cg::grid_group& grid, XcdBarrier& bar, unsigned* barw, volatile LAS unsigned* MISC) {
    const int tid = threadIdx.x, lane = tid & 63, wave = __builtin_amdgcn_readfirstlane(tid >> 6);
    const int G = gridDim.x, bid = blockIdx.x, gw = bid * 8 + wave, ngw = G * 8;
    unsigned char* ws = a.ws; float* out = a.out;
    float* mods = (float*)(ws + WS_MODS);
    bf16_t *Wi = (bf16_t*)(ws + WS_WIN), *Wao = (bf16_t*)(ws + WS_WAO), *Wco = (bf16_t*)(ws + WS_WCO), *Wo = (bf16_t*)(ws + WS_WOUT), *Wf1 = (bf16_t*)(ws + WS_WF1), *Wf2 = (bf16_t*)(ws + WS_WF2);
    bf16_t *H = (bf16_t*)(ws + WS_H), *Q = (bf16_t*)(ws + WS_Q), *Kb = (bf16_t*)(ws + WS_K), *Vb = (bf16_t*)(ws + WS_V), *U = (bf16_t*)(ws + WS_U), *GA = (bf16_t*)(ws + WS_GA), *GC = (bf16_t*)(ws + WS_GC);
    bf16_t *PB = (bf16_t*)(ws + WS_ATT);
    bf16_t *ATT = (bf16_t*)(ws + WS_Q), *CV = (bf16_t*)(ws + WS_CV), *MM = (bf16_t*)(ws + WS_GA), *ACT = (bf16_t*)(ws + WS_ACT);
    if (LIM > 0) {
        for (int it = bid; it < 192; it += G) mods_item(lds, a.in[I_CP], a.in[I_CS], a.in[I_WADA], a.in[I_BADA], mods, it, tid);
    }
    if (FIRST) { grid.sync();
                 bar = xcd_barrier_post(barw, MISC); }
    else xcd_barrier(bar);
    if (LIM > 1) {
        __syncthreads();
        LAS float* scr = (LAS float*)(lds + wave * 16384);
        constexpr int T_IN = 16 * 120, T_AO = 8 * 32, T_CO = 8 * 32, T_OUT = 16 * 32, T_F1 = 16 * 176, T_F2 = 44 * 32;
        for (int it = gw; it < T_IN + T_AO + T_CO + T_OUT + T_F1 + T_F2; it += ngw) {
            int r = it;
            if (r < T_IN) { transpose_item(a.in[I_WIN], D, NIN, Wi, 1, scr, r, lane); continue; } r -= T_IN;
            if (r < T_AO) { transpose_item(a.in[I_WAO], 512, D, Wao, 0, scr, r, lane); continue; } r -= T_AO;
            if (r < T_CO) { transpose_item(a.in[I_WCO], 512, D, Wco, 0, scr, r, lane); continue; } r -= T_CO;
            if (r < T_OUT) { transpose_item(a.in[I_WOUT], D, D, Wo, 0, scr, r, lane); continue; } r -= T_OUT;
            if (r < T_F1) { transpose_item(a.in[I_WF1], D, 2 * FF, Wf1, 2, scr, r, lane); continue; } r -= T_F1;
            transpose_item(a.in[I_WF2], FF, D, Wf2, 0, scr, r, lane);
        }
        const int gt = bid * 512 + tid, ngt = G * 512;
        for (int i0 = gt; i0 < 128 * 3968; i0 += 4 * ngt) {
            f32x4 kk[4], vv[4];
#pragma unroll
            for (int u = 0; u < 4; ++u) { const int i = min(i0 + u * ngt, 128 * 3968 - 1), b = i / 3968, o = i % 3968;
                kk[u] = ((const f32x4*)(a.in[I_SK] + (size_t)b * 16384 + 512))[o]; vv[u] = ((const f32x4*)(a.in[I_SV] + (size_t)b * 16384 + 512))[o]; }
#pragma unroll
            for (int u = 0; u < 4; ++u) { const int i = i0 + u * ngt; if (i < 128 * 3968) { const int b = i / 3968, o = i % 3968;
                ((f32x4*)(out + O_KS + (size_t)b * 16384))[o] = kk[u]; ((f32x4*)(out + O_VS + (size_t)b * 16384))[o] = vv[u]; } }
        }
        for (int i0 = gt; i0 < 128 * 3328; i0 += 4 * ngt) {
            f32x4 cc[4];
#pragma unroll
            for (int u = 0; u < 4; ++u) { const int i = min(i0 + u * ngt, 128 * 3328 - 1), b = i / 3328, o = i % 3328; cc[u] = ((const f32x4*)(a.in[I_SC] + (size_t)b * 15360 + 2048))[o]; }
#pragma unroll
            for (int u = 0; u < 4; ++u) { const int i = i0 + u * ngt; if (i < 128 * 3328) { const int b = i / 3328, o = i % 3328; ((f32x4*)(out + O_CS + (size_t)b * 15360))[o] = cc[u]; } }
        }
        }
    if (LIM > 1) { rows_norm_mod(a.in[I_XP], a.in[I_XS], a.in[I_N1], mods, 0, H, out, gw, ngw, lane);
        xcd_barrier(bar); }
    if (LIM > 2) {
        __syncthreads();
        pg8::Gemm g{H, Wi, MT, NIN, D}; pg8::StaticOrder S; S.init(MT, NIN, D, G, bid);
        EpiIn E{Q, Kb, Vb, U, GA, GC, out};
        pg8::gemm_phase<EpiIn, pg8::StaticOrder>(lds, g, S, E, nullptr);
        xcd_barrier(bar);
    }
    if (LIM > 3) {
        __syncthreads();
        for (int it = bid; it < 512; it += G) attn_prompt_item(lds, Q, Kb, Vb, ATT, a.in[I_SINKS], it, tid);
        for (int it = gw; it < 1024; it += ngw) attn_sample_item(lds + SATT_OFF + wave * 4096, Q, Kb, Vb, a.in[I_SK], a.in[I_SV], ATT, a.in[I_SINKS], it, lane);
        __syncthreads();
        if (G == 256) { const int c0_ = bid < 128 ? bid * 7 : 896 + (bid - 128) * 9, n_ = bid < 128 ? 7 : 9;
            conv_phase<8, false>(lds, U, a.in[I_SC], a.in[I_CONVW], a.in[I_CONVB], a.in[I_LNG], a.in[I_LNB], CV, c0_, c0_ + n_, 1, tid); }
        else conv_phase<8, false>(lds, U, a.in[I_SC], a.in[I_CONVW], a.in[I_CONVB], a.in[I_LNG], a.in[I_LNB], CV, bid, 2048, G, tid);
        conv_phase<4, true>(lds, U, a.in[I_SC], a.in[I_CONVW], a.in[I_CONVB], a.in[I_LNG], a.in[I_LNB], CV, G - 1 - bid, 64, G, tid);
        xcd_barrier(bar);
    }
    if (LIM > 4) {
        __syncthreads();
        pg8::Gemm g{ATT, Wao, MT, D, 512, CV, Wco}; MergeOrder S; S.init(G, bid); EpiMerge E{GA, GC, MM};
        pg8::gemm_phase<EpiMerge, MergeOrder>(lds, g, S, E, nullptr);
        if (bid < 16) { __syncthreads(); SampleHalfOrder S2; S2.init(G, bid); EpiHalf E2{GA, GC, MM, PB - (size_t)TP * D}; pg8::gemm_phase<EpiHalf, SampleHalfOrder>(lds, g, S2, E2, nullptr); }
        xcd_barrier(bar);
    }
    if (LIM > 5) {
        __syncthreads();
        pg8::Gemm g{MM, Wo, MT, D, D, PB - (size_t)TP * D, Wo}; TailSplitOrder<1> S; S.init(D, 2, G, bid);
        EpiRes E{a.in[I_XP], mods + 2 * 1024, out};
        pg8::gemm_phase<EpiRes, TailSplitOrder<1>>(lds, g, S, E, nullptr);
        xcd_barrier(bar);
    }
    if (LIM > 6) { rows_norm_mod(out, out + (size_t)TP * D, a.in[I_N2], mods, 3, H, nullptr, gw, ngw, lane);
        xcd_barrier(bar); }
    if (LIM > 7) {
        __syncthreads();
        pg8::Gemm g{H, Wf1, MT, 2 * FF, D}; pg8::StaticOrder S; S.init(MT, 2 * FF, D, G, bid);
        EpiSwi E{ACT};
        pg8::gemm_phase<EpiSwi, pg8::StaticOrder>(lds, g, S, E, nullptr);
        xcd_barrier(bar);
    }
    if (LIM > 8) {
        __syncthreads();
        pg8::Gemm g{ACT, Wf2, MT, D, FF}; TailSplitOrder<0> S; S.init(FF, 11, G, bid);
        EpiRes E{out, mods + 5 * 1024, out};
        pg8::gemm_phase<EpiRes, TailSplitOrder<0>>(lds, g, S, E, nullptr);
        xcd_barrier(bar);
    }
    if (LIM > 9) rows_final(out, out, a.in[I_FNG], gw, ngw, lane);
}

#ifndef PREFIX
#define PREFIX 0
#endif
__global__ void __launch_bounds__(512, 2) mega(Args a) {
    extern __shared__ __attribute__((aligned(16))) unsigned char lds_raw[];
    cg::grid_group grid = cg::this_grid();
    LAS unsigned char* lds = (LAS unsigned char*)lds_raw;
    unsigned* barw = (unsigned*)a.ws;
    volatile LAS unsigned* MISC = (volatile LAS unsigned*)(lds + MISC_OFF);
    if (threadIdx.x < 2) MISC[threadIdx.x] = 0u;
    if (blockIdx.x == 0) for (int i = threadIdx.x; i < XCD_BAR_WORDS; i += 512) __hip_atomic_store(barw + i, 0u, __ATOMIC_RELAXED, __HIP_MEMORY_SCOPE_AGENT);
    __syncthreads();
    XcdBarrier bar; bar.bar = barw; bar.x = 0; bar.st = MISC;
#if PREFIX > 0
    program<PREFIX, true>(a, lds, grid, bar, barw, MISC);
    asm volatile("" ::: "memory");
    program<10, false>(a, lds, grid, bar, barw, MISC);
#else
    program<10, true>(a, lds, grid, bar, barw, MISC);
#endif
}

extern "C" void kernel_launch(void* const* d_in, const int* in_sizes, int n_in, void* d_out, int out_size, void* d_ws, size_t ws_size, hipStream_t stream) {
    static int grid = 0;
    if (grid == 0) {
        int dev = 0, cus = 0, per_cu = 0;
        if (n_in != 23 || ws_size < WS_END) { fprintf(stderr, "kernel_launch: unexpected n_in %d / ws %zu\n", n_in, ws_size); grid = -1; return; }
        (void)hipGetDevice(&dev);
        (void)hipDeviceGetAttribute(&cus, hipDeviceAttributeMultiprocessorCount, dev);
        if (hipFuncSetAttribute((const void*)mega, hipFuncAttributeMaxDynamicSharedMemorySize, LDS_BYTES) != hipSuccess) { fprintf(stderr, "kernel_launch: hipFuncSetAttribute failed\n"); grid = -1; return; }
        if (hipOccupancyMaxActiveBlocksPerMultiprocessor(&per_cu, (const void*)mega, 512, LDS_BYTES) != hipSuccess || per_cu < 1) { fprintf(stderr, "kernel_launch: occupancy query says %d\n", per_cu); (void)hipGetLastError(); grid = -1; return; }
        grid = cus;
    }
    if (grid < 0) return;
    Args a{};
    for (int i = 0; i < 23; ++i) a.in[i] = (const float*)d_in[i];
    a.out = (float*)d_out; a.ws = (unsigned char*)d_ws; a.ph_lo = 0; a.ph_hi = NPH;
    void* args[] = {&a};
    hipError_t e = hipLaunchCooperativeKernel((const void*)mega, dim3(grid), dim3(512), args, LDS_BYTES, stream);
    if (e != hipSuccess) fprintf(stderr, "cooperative launch failed: %s (grid %d)\n", hipGetErrorString(e), grid);
}
```
